# Optimizing an MI355X kernel written in HIP

```python
import math
import jax, jax.numpy as jnp
from jax import lax
import numpy as np

D_MODEL = 2048
BATCH = 2
SEQ = 4096
DEPTH = 4

PLE_DIM = 256
ATTN_WIDTH = D_MODEL // 2
POOL_WIDTH = D_MODEL - ATTN_WIDTH
HEAD_DIM = 64
N_HEADS = ATTN_WIDTH // HEAD_DIM
N_KV_HEADS = max(1, N_HEADS // 8)
KV_GROUP = N_HEADS // N_KV_HEADS
WINDOW = 128
BLOCK = WINDOW
POOL_WINDOWS = (2, 4, 8, 16)
N_POOL_GROUPS = len(POOL_WINDOWS)
POOL_GROUP_DIM = POOL_WIDTH // N_POOL_GROUPS
REL_BUCKETS = 32
REL_MAX_DIST = 128
LN_EPS = 1e-5
DEEPNORM_ALPHA = (2.0 * DEPTH) ** 0.25
DEEPNORM_BETA = (8.0 * DEPTH) ** -0.25
Q_COLS = N_HEADS * HEAD_DIM
KV_COLS = N_KV_HEADS * HEAD_DIM
SPLIT_SIZES = (Q_COLS, KV_COLS, KV_COLS, ATTN_WIDTH, POOL_WIDTH, POOL_WIDTH)
SPLIT_POINTS = tuple(int(c) for c in np.cumsum(SPLIT_SIZES)[:-1])
IN_COLS = int(sum(SPLIT_SIZES))

kernel_name = "hymba_swa_sink_pool_deepnorm"


def t5_causal_bucket(dist):
    max_exact = REL_BUCKETS // 2
    d = jnp.maximum(dist, 0)
    d_f = jnp.maximum(d, 1).astype(jnp.float32)
    large = max_exact + (jnp.log(d_f / max_exact) / math.log(REL_MAX_DIST / max_exact)
                         * (REL_BUCKETS - max_exact)).astype(jnp.int32)
    large = jnp.minimum(large, REL_BUCKETS - 1)
    return jnp.where(d < max_exact, d, large)


def band_geometry():
    qq = jnp.arange(BLOCK)[:, None]
    kk = jnp.arange(2 * BLOCK)[None, :]
    dist = qq + BLOCK - kk
    in_window = (dist >= 0) & (dist < WINDOW)
    return dist, in_window


def layer_norm(x, gain, bias):
    xf = x.astype(jnp.float32)
    mu = jnp.mean(xf, axis=-1, keepdims=True)
    var = jnp.mean(jnp.square(xf - mu), axis=-1, keepdims=True)
    y = (xf - mu) * lax.rsqrt(var + LN_EPS)
    return (y * gain.astype(jnp.float32) + bias.astype(jnp.float32)).astype(x.dtype)


def banded_sink_attention(q, k, v, sinks, bias_hqk, valid):
    B, S, _ = q.shape
    nblk = S // BLOCK
    qb = q.reshape(B, nblk, BLOCK, N_KV_HEADS, KV_GROUP, HEAD_DIM)
    pad = ((0, 0), (BLOCK, 0), (0, 0))
    kp = jnp.pad(k, pad).reshape(B, nblk + 1, BLOCK, N_KV_HEADS, HEAD_DIM)
    vp = jnp.pad(v, pad).reshape(B, nblk + 1, BLOCK, N_KV_HEADS, HEAD_DIM)
    kb = jnp.concatenate([kp[:, :-1], kp[:, 1:]], axis=2)
    vb = jnp.concatenate([vp[:, :-1], vp[:, 1:]], axis=2)
    scale = 1.0 / math.sqrt(HEAD_DIM)
    scores = jnp.einsum('bnqhgd,bnkhd->bnhgqk', qb, kb).astype(jnp.float32) * scale
    scores = scores + bias_hqk[None, None]
    scores = jnp.where(valid[None, :, None, None], scores, -1e30)
    s_sink = sinks.astype(jnp.float32).reshape(N_KV_HEADS, KV_GROUP)[None, None, :, :, None, None]
    m = jnp.maximum(jnp.max(scores, axis=-1, keepdims=True), s_sink)
    e = jnp.exp(scores - m)
    denom = jnp.sum(e, axis=-1, keepdims=True) + jnp.exp(s_sink - m)
    probs = (e / denom).astype(v.dtype)
    out = jnp.einsum('bnhgqk,bnkhd->bnqhgd', probs, vb)
    return out.reshape(B, S, N_HEADS * HEAD_DIM)


def multiscale_pool(u, w_pool, pool_scale):
    B, S, _ = u.shape
    ug = u.reshape(B, S, N_POOL_GROUPS, POOL_GROUP_DIM).astype(jnp.float32)
    cs = jnp.cumsum(ug, axis=1)
    t = jnp.arange(S)
    means = []
    for g, w in enumerate(POOL_WINDOWS):
        c = cs[:, :, g]
        lagged = jnp.pad(c[:, :S - w], ((0, 0), (w, 0), (0, 0)))
        count = jnp.minimum(t + 1, w).astype(jnp.float32)[None, :, None]
        means.append((c - lagged) / count)
    pooled = jnp.stack(means, axis=2)
    diff = (pooled - ug).astype(u.dtype)
    mixed = jnp.einsum('bsgc,gcd->bsgd', diff, w_pool)
    return mixed.reshape(B, S, POOL_WIDTH) * pool_scale


def hybrid_layer(x, p_i, w_in, b_in, w_out, sinks, w_pool, pool_scale, w_ple, w_gate_ple,
                 ln_gain, ln_bias, bias_hqk, valid):
    h = jnp.einsum('bsd,dc->bsc', x, w_in) + b_in
    q, k, v, g_attn, u_pool, g_pool = jnp.split(h, SPLIT_POINTS, axis=-1)
    a = banded_sink_attention(q, k, v, sinks, bias_hqk, valid) * jax.nn.silu(g_attn)
    b = multiscale_pool(u_pool, w_pool, pool_scale) * jax.nn.silu(g_pool)
    mix = jnp.einsum('bsc,cd->bsd', jnp.concatenate([a, b], axis=-1), w_out)
    ple = jax.nn.sigmoid(jnp.einsum('bsd,de->bse', x, w_gate_ple)) * jnp.einsum('bsp,pd->bsd', p_i, w_ple)
    return layer_norm(DEEPNORM_ALPHA * x + mix + ple, ln_gain, ln_bias)


def setup_inputs(seed: int = 0) -> dict:
    key = jax.random.key(seed)
    ks = jax.random.split(key, 14)
    f32 = jnp.float32
    x = jax.random.normal(ks[0], (BATCH, SEQ, D_MODEL), f32)
    p = jax.random.normal(ks[1], (DEPTH, BATCH, SEQ, PLE_DIM), f32)
    w_in = jax.random.normal(ks[2], (DEPTH, D_MODEL, IN_COLS), f32) * D_MODEL ** -0.5
    b_in = jax.random.normal(ks[3], (DEPTH, IN_COLS), f32) * 0.02
    w_out = jax.random.normal(ks[4], (DEPTH, D_MODEL, D_MODEL), f32) * (D_MODEL ** -0.5 * DEEPNORM_BETA)
    attn_sinks = jax.random.normal(ks[5], (DEPTH, N_HEADS), f32) * 0.5
    rel_bias = jax.random.normal(ks[6], (REL_BUCKETS, N_HEADS), f32) * 0.1
    w_pool = jax.random.normal(ks[7], (DEPTH, N_POOL_GROUPS, POOL_GROUP_DIM, POOL_GROUP_DIM), f32) * POOL_GROUP_DIM ** -0.5
    pool_scale = 1.0 + 0.1 * jax.random.normal(ks[8], (DEPTH, POOL_WIDTH), f32)
    w_ple = jax.random.normal(ks[9], (DEPTH, PLE_DIM, D_MODEL), f32) * PLE_DIM ** -0.5
    w_gate_ple = jax.random.normal(ks[10], (DEPTH, D_MODEL, D_MODEL), f32) * D_MODEL ** -0.5
    ln_gain = 1.0 + 0.02 * jax.random.normal(ks[11], (DEPTH, D_MODEL), f32)
    ln_bias = 0.02 * jax.random.normal(ks[12], (DEPTH, D_MODEL), f32)
    return {"x": x, "p": p, "w_in": w_in, "b_in": b_in, "w_out": w_out,
            "attn_sinks": attn_sinks, "rel_bias": rel_bias, "w_pool": w_pool,
            "pool_scale": pool_scale, "w_ple": w_ple, "w_gate_ple": w_gate_ple,
            "ln_gain": ln_gain, "ln_bias": ln_bias}


def reference(x, p, w_in, b_in, w_out, attn_sinks, rel_bias, w_pool, pool_scale, w_ple,
              w_gate_ple, ln_gain, ln_bias):
    S = x.shape[1]
    nblk = S // BLOCK
    dist, in_window = band_geometry()
    bias_hqk = jnp.transpose(rel_bias[t5_causal_bucket(dist)], (2, 0, 1)).astype(jnp.float32)
    bias_hqk = bias_hqk.reshape(N_KV_HEADS, KV_GROUP, BLOCK, 2 * BLOCK)
    k_pos = (jnp.arange(nblk) * BLOCK - BLOCK)[:, None, None] + jnp.arange(2 * BLOCK)[None, None, :]
    valid = in_window[None] & (k_pos >= 0)
    for i in range(DEPTH):
        x = hybrid_layer(x, p[i], w_in[i], b_in[i], w_out[i], attn_sinks[i], w_pool[i],
                         pool_scale[i], w_ple[i], w_gate_ple[i], ln_gain[i], ln_bias[i],
                         bias_hqk, valid)
    return x
```

```cpp
#include <hip/hip_runtime.h>
#include <cstdio>
#include <cstdint>

#ifndef MK_N_LAUNCHES
#define MK_N_LAUNCHES 1
#endif
#ifndef PH_MASK
#define PH_MASK 31
#endif
#ifndef T_NAIVE
#define T_NAIVE 1
#endif

constexpr int BATCH = 2, SEQ = 4096, DM = 2048, DEPTH = 4, MTOK = BATCH * SEQ;
constexpr int PLE = 256, NHEAD = 16, HD = 64, NKV = 2, WINDOW = 128;
constexpr int IN_COLS = 4352;
constexpr int N1 = IN_COLS + DM;
constexpr int K2 = PLE + DM;
constexpr int HQ = 0, HK = 1024, HV = 1152, HGA = 1280, HU = 2304, HGB = 3328, HGATE = 4352, LDH = N1;
constexpr int AC_P = 0, AC_A = 256, AC_B = 1280, LDAC = K2;
constexpr float LN_EPS = 1e-5f;
constexpr float ALPHA = 1.6817928305074290f;
constexpr float LOG2E = 1.4426950408889634f;
constexpr float QSCALE = 0.125f * LOG2E;

namespace pg8 {
#define PG8_LAS __attribute__((address_space(3)))
typedef unsigned short bf16_t;
typedef short bf16x8 __attribute__((ext_vector_type(8)));
typedef float f32x4 __attribute__((ext_vector_type(4)));
typedef unsigned u32x4 __attribute__((ext_vector_type(4)));
constexpr int BM = 256, BK = 64, HALF = 128, HTB = HALF * BK * 2, STAGE_BYTES = 8 * HTB, NXCD = 8, WGM = 8;

__host__ __device__ __forceinline__ int lds_byte(int r, int c) { const int st = (r >> 4) * 2 + (c >> 5), rr = r & 15, cc = c & 31, ob = rr * 64 + cc * 2; return st * 1024 + (ob ^ (((ob >> 9) & 1) << 5)); }
__host__ __device__ __forceinline__ void stage_rc(int b, int& R, int& C) { const int st = b / 1024, sb = b % 1024, swz = sb ^ (((sb >> 9) & 1) << 5); R = (st >> 1) * 16 + swz / 64; C = (st & 1) * 32 + (swz % 64) / 2; }
__host__ __device__ __forceinline__ int perm32(int rho) { const int n = rho >> 4, i = rho & 15; return 8 * (i >> 2) + 4 * n + (i & 3); }

struct Unit { int pm, pn; };
struct Gemm { const bf16_t* A; const bf16_t* Bt; int M, N, K; };

struct StaticOrder {
    int nM, nN, nwg, G, c;
    __host__ __device__ void init(int M, int N, int G_, int c_) { nM = M / BM; nN = N / BM; nwg = nM * nN; G = G_; c = c_; }
    __host__ __device__ bool next(int i, Unit& u) const {
        const long L = (long)i * G + c; if (L >= nwg) return false;
        int wgid = (int)L; { const int q = nwg / NXCD, r = nwg % NXCD, xcd = wgid % NXCD, off = wgid / NXCD; wgid = (xcd < r ? xcd * (q + 1) : r * (q + 1) + (xcd - r) * q) + off; }
        const int nig = WGM * nN, gid = wgid / nig, fm = gid * WGM, gsz = (nM - fm) < WGM ? (nM - fm) : WGM;
        u.pm = fm + ((wgid % nig) % gsz); u.pn = (wgid % nig) / gsz; return true;
    }
};

__device__ __forceinline__ unsigned cvt_pk_bf16(float lo, float hi) { unsigned r; asm volatile("v_cvt_pk_bf16_f32 %0, %1, %2" : "=v"(r) : "v"(lo), "v"(hi)); return r; }
__device__ __forceinline__ float bf_lo(unsigned w) { return __uint_as_float(w << 16); }
__device__ __forceinline__ float bf_hi(unsigned w) { return __uint_as_float(w & 0xffff0000u); }
__device__ __forceinline__ float sigmoidf_fast(float v) { return __builtin_amdgcn_rcpf(1.0f + __builtin_amdgcn_exp2f(-LOG2E * v)); }


struct EpiH {
    static constexpr bool PERM = true; static constexpr int HOOK_T = 0;
    bf16_t* H; const float* bias;
    __device__ __forceinline__ void hook(f32x4 (&)[2][2][4][2], const Unit&, int, int, int, int) const {}
    __device__ __forceinline__ void operator()(const f32x4 (&acc)[2][2][4][2], const Unit& u, int wr, int wc, int fr, int fq) const {
        const int row0 = u.pm * BM + wr * 64 + fr, col0 = u.pn * BM + wc * 32 + 8 * fq;
        const int pn = u.pn; const int mode = pn < 4 ? 0 : (pn == 4 ? 1 : (pn < 9 ? 2 : (pn < 13 ? 1 : (pn < 17 ? 2 : 3))));
        f32x4 bv[2][2];
#pragma unroll
        for (int bj = 0; bj < 2; ++bj)
#pragma unroll
            for (int n = 0; n < 2; ++n) bv[bj][n] = (mode != 3) ? *(const f32x4*)(bias + col0 + bj * HALF + 4 * n) : (f32x4){0.f, 0.f, 0.f, 0.f};
#pragma unroll
        for (int ai = 0; ai < 2; ++ai)
#pragma unroll
            for (int m = 0; m < 4; ++m) { bf16_t* rowp = H + (size_t)(row0 + ai * HALF + m * 16) * LDH + col0;
#pragma unroll
                for (int bj = 0; bj < 2; ++bj) { f32x4 v0 = acc[ai][bj][m][0] + bv[bj][0], v1 = acc[ai][bj][m][1] + bv[bj][1];
                    if (mode == 0) { v0 = v0 * QSCALE; v1 = v1 * QSCALE; }
                    else if (mode == 2) {
#pragma unroll
                        for (int e = 0; e < 4; ++e) { v0[e] = v0[e] * sigmoidf_fast(v0[e]); v1[e] = v1[e] * sigmoidf_fast(v1[e]); } }
                    else if (mode == 3) {
#pragma unroll
                        for (int e = 0; e < 4; ++e) { v0[e] = sigmoidf_fast(v0[e]); v1[e] = sigmoidf_fast(v1[e]); } }
                    u32x4 w; w.x = cvt_pk_bf16(v0[0], v0[1]); w.y = cvt_pk_bf16(v0[2], v0[3]); w.z = cvt_pk_bf16(v1[0], v1[1]); w.w = cvt_pk_bf16(v1[2], v1[3]);
                    *(u32x4*)(rowp + bj * HALF) = w; } }
    }
};

struct EpiY {
    static constexpr bool PERM = true; static constexpr int HOOK_T = PLE / BK;
    const bf16_t* H; const float* xres; float* Y;
    __device__ __forceinline__ void hook(f32x4 (&acc)[2][2][4][2], const Unit& u, int wr, int wc, int fr, int fq) const {
        int opq = 0; asm volatile("" : "+v"(opq));
        const int row0 = u.pm * BM + wr * 64 + fr + opq, col0 = u.pn * BM + wc * 32 + 8 * fq;
#pragma unroll
        for (int ai = 0; ai < 2; ++ai)
#pragma unroll
            for (int mp = 0; mp < 2; ++mp) { u32x4 g[2][2];
#pragma unroll
                for (int mm = 0; mm < 2; ++mm)
#pragma unroll
                    for (int bj = 0; bj < 2; ++bj) g[mm][bj] = *(const u32x4*)(H + (size_t)(row0 + ai * HALF + (2 * mp + mm) * 16) * LDH + HGATE + col0 + bj * HALF);
#pragma unroll
                for (int mm = 0; mm < 2; ++mm)
#pragma unroll
                    for (int bj = 0; bj < 2; ++bj) { const int m = 2 * mp + mm; const u32x4 gg = g[mm][bj];
                        acc[ai][bj][m][0] = acc[ai][bj][m][0] * (f32x4){bf_lo(gg.x), bf_hi(gg.x), bf_lo(gg.y), bf_hi(gg.y)};
                        acc[ai][bj][m][1] = acc[ai][bj][m][1] * (f32x4){bf_lo(gg.z), bf_hi(gg.z), bf_lo(gg.w), bf_hi(gg.w)}; }
                asm volatile("" ::: "memory"); }
    }
    __device__ __forceinline__ void operator()(const f32x4 (&acc)[2][2][4][2], const Unit& u, int wr, int wc, int fr, int fq) const {
        const int row0 = u.pm * BM + wr * 64 + fr, col0 = u.pn * BM + wc * 32 + 8 * fq;
#pragma unroll
        for (int ai = 0; ai < 2; ++ai)
#pragma unroll
            for (int mp = 0; mp < 2; ++mp) { f32x4 xr[2][2][2];
#pragma unroll
                for (int mm = 0; mm < 2; ++mm)
#pragma unroll
                    for (int bj = 0; bj < 2; ++bj)
#pragma unroll
                        for (int n = 0; n < 2; ++n) xr[mm][bj][n] = *(const f32x4*)(xres + (size_t)(row0 + ai * HALF + (2 * mp + mm) * 16) * DM + col0 + bj * HALF + 4 * n);
#pragma unroll
                for (int mm = 0; mm < 2; ++mm)
#pragma unroll
                    for (int bj = 0; bj < 2; ++bj)
#pragma unroll
                        for (int n = 0; n < 2; ++n) *(f32x4*)(Y + (size_t)(row0 + ai * HALF + (2 * mp + mm) * 16) * DM + col0 + bj * HALF + 4 * n) = xr[mm][bj][n] * ALPHA + acc[ai][bj][2 * mp + mm][n];
                asm volatile("" ::: "memory"); }
    }
};

template <class Epi, class Sched, bool ALIGN_EPI>
__device__ __forceinline__ void gemm_phase(PG8_LAS unsigned char* lds, const Gemm g, const Sched& S, const Epi& E) {
    int tid_ = threadIdx.x; asm volatile("" : "+v"(tid_));
    const int tid = tid_, wid = __builtin_amdgcn_readfirstlane(tid >> 6), lane = tid & 63, wr = wid >> 2, wc = wid & 3, fr = lane & 15, fq = lane >> 4;
    const int K = g.K, nt = K / BK;
    unsigned voffA[2], voffB[2];
#pragma unroll
    for (int i = 0; i < 2; ++i) { int R, C; stage_rc(tid * 16 + i * 8192, R, C); const int Rb = Epi::PERM ? ((R & ~31) + perm32(R & 31)) : R;
        voffA[i] = (unsigned)(R * K + C) * 2u; voffB[i] = (unsigned)(Rb * K + C) * 2u; }
    const size_t kstep = (size_t)(BK * 2);
    const size_t hstep = (size_t)HALF * K * 2;
    const size_t tstep = 2 * hstep;
    const unsigned ldsw = (unsigned)wid * 1024u;
    const int aoff = lds_byte(wr * 64 + fr, fq * 8), boff = lds_byte(wc * 32 + fr, fq * 8);
#define PG8_SA(b, h) (((b) * 2 + (h)) * HTB)
#define PG8_SB(b, h) ((4 + (b) * 2 + (h)) * HTB)
#define PG8_STAGE(bufoff, gbase, voff) do { _Pragma("unroll") for (int _i = 0; _i < 2; ++_i) \
        __builtin_amdgcn_global_load_lds((const unsigned*)((const char*)(gbase) + (voff)[_i]), (PG8_LAS unsigned*)(lds + (bufoff) + ldsw + _i * 8192), 16, 0, 0); } while (0)
#define PG8_LDA(dst, b, h) do { _Pragma("unroll") for (int m = 0; m < 4; ++m) _Pragma("unroll") for (int k = 0; k < 2; ++k) dst[m][k] = *(const PG8_LAS bf16x8*)(lds + PG8_SA(b, h) + aoff + m * 2048 + k * 1024); } while (0)
#define PG8_LDB(dst, b, h) do { _Pragma("unroll") for (int n = 0; n < 2; ++n) _Pragma("unroll") for (int k = 0; k < 2; ++k) dst[n][k] = *(const PG8_LAS bf16x8*)(lds + PG8_SB(b, h) + boff + n * 2048 + k * 1024); } while (0)
#define PG8_MMA(ai, bj, At, Bt) do { __builtin_amdgcn_s_setprio(1); _Pragma("unroll") for (int m = 0; m < 4; ++m) _Pragma("unroll") for (int n = 0; n < 2; ++n) _Pragma("unroll") for (int k = 0; k < 2; ++k) \
        acc[ai][bj][m][n] = __builtin_amdgcn_mfma_f32_16x16x32_bf16(Bt[n][k], At[m][k], acc[ai][bj][m][n], 0, 0, 0); __builtin_amdgcn_s_setprio(0); } while (0)
#define PG8_WAIT_V(n) asm volatile("s_waitcnt vmcnt(" #n ")" ::: "memory")
#define PG8_WAIT_L(n) asm volatile("s_waitcnt lgkmcnt(" #n ")" ::: "memory")
#define PG8_BAR __builtin_amdgcn_s_barrier()
#define PG8_SCHED __builtin_amdgcn_sched_barrier(0)
    Unit cur, nxt; int ui = 0;
    if (!S.next(0, cur)) return;
    f32x4 acc[2][2][4][2];
#pragma unroll
    for (int a = 0; a < 2; ++a)
#pragma unroll
        for (int b = 0; b < 2; ++b)
#pragma unroll
            for (int m = 0; m < 4; ++m)
#pragma unroll
                for (int n = 0; n < 2; ++n) acc[a][b][m][n] = (f32x4){0.f, 0.f, 0.f, 0.f};
    bf16x8 At[4][2], B0[2][2], B1[2][2];
    const char* cA = (const char*)g.A + (size_t)cur.pm * tstep; const char* cB = (const char*)g.Bt + (size_t)cur.pn * tstep;
    PG8_STAGE(PG8_SB(0, 0), cB, voffB); PG8_STAGE(PG8_SB(0, 1), cB + hstep, voffB); PG8_STAGE(PG8_SA(0, 0), cA, voffA); PG8_STAGE(PG8_SA(0, 1), cA + hstep, voffA);
    if (wr == 1) PG8_BAR;
    PG8_WAIT_V(2); PG8_BAR;
    PG8_STAGE(PG8_SB(1, 0), cB + kstep, voffB); PG8_STAGE(PG8_SA(1, 0), cA + kstep, voffA); PG8_STAGE(PG8_SB(1, 1), cB + hstep + kstep, voffB);
    PG8_WAIT_V(6); PG8_BAR;
    for (;;) {
        const bool has_next = S.next(ui + 1, nxt);
        const char* nA = has_next ? (const char*)g.A + (size_t)nxt.pm * tstep : cA; const char* nB = has_next ? (const char*)g.Bt + (size_t)nxt.pn * tstep : cB;
        for (int t = 0; t < nt; t += 2) {
            if (Epi::HOOK_T > 0 && t == Epi::HOOK_T) E.hook(acc, cur, wr, wc, fr, fq);
            const bool last = (t == nt - 2);
            const char* a1 = cA + (size_t)(t + 1) * kstep;
            const char* a2 = last ? nA : cA + (size_t)(t + 2) * kstep; const char* b2 = last ? nB : cB + (size_t)(t + 2) * kstep;
            const char* a3 = a2 + kstep; const char* b3 = b2 + kstep;
            PG8_LDB(B0, 0, 0); PG8_LDB(B1, 0, 1); PG8_SCHED; PG8_LDA(At, 0, 0); PG8_STAGE(PG8_SA(1, 1), a1 + hstep, voffA);
            PG8_WAIT_V(8); PG8_WAIT_L(0); PG8_BAR; PG8_MMA(0, 0, At, B0); PG8_MMA(0, 1, At, B1); PG8_BAR; PG8_SCHED;
            PG8_LDA(At, 0, 1); PG8_STAGE(PG8_SB(0, 0), b2, voffB); PG8_STAGE(PG8_SB(0, 1), b2 + hstep, voffB); PG8_STAGE(PG8_SA(0, 0), a2, voffA);
            PG8_WAIT_V(8); PG8_WAIT_L(0); PG8_BAR; PG8_MMA(1, 0, At, B0); PG8_MMA(1, 1, At, B1); PG8_BAR; PG8_SCHED;
            PG8_LDB(B0, 1, 0); PG8_LDB(B1, 1, 1); PG8_SCHED; PG8_LDA(At, 1, 0); PG8_STAGE(PG8_SA(0, 1), a2 + hstep, voffA);
            PG8_WAIT_V(8); PG8_WAIT_L(0); PG8_BAR; PG8_MMA(0, 0, At, B0); PG8_MMA(0, 1, At, B1); PG8_BAR; PG8_SCHED;
            PG8_LDA(At, 1, 1); PG8_STAGE(PG8_SB(1, 0), b3, voffB); PG8_STAGE(PG8_SB(1, 1), b3 + hstep, voffB); PG8_STAGE(PG8_SA(1, 0), a3, voffA);
            PG8_WAIT_V(8); PG8_WAIT_L(0); PG8_BAR; PG8_MMA(1, 0, At, B0); PG8_MMA(1, 1, At, B1); PG8_BAR; PG8_SCHED;
        }
        if constexpr (ALIGN_EPI) { if (wr == 0) PG8_BAR; }
        E(acc, cur, wr, wc, fr, fq);
        if (!has_next) break;
#pragma unroll
        for (int a = 0; a < 2; ++a)
#pragma unroll
            for (int b = 0; b < 2; ++b)
#pragma unroll
                for (int m = 0; m < 4; ++m)
#pragma unroll
                    for (int n = 0; n < 2; ++n) acc[a][b][m][n] = (f32x4){0.f, 0.f, 0.f, 0.f};
        cur = nxt; cA = nA; cB = nB; ++ui;
        if constexpr (ALIGN_EPI) { if (wr == 1) PG8_BAR; }
    }
    PG8_WAIT_V(0);
    if constexpr (!ALIGN_EPI) { if (wr == 0) PG8_BAR; }
    PG8_BAR;
#undef PG8_SA
#undef PG8_SB
#undef PG8_STAGE
#undef PG8_LDA
#undef PG8_LDB
#undef PG8_MMA
#undef PG8_WAIT_V
#undef PG8_WAIT_L
#undef PG8_BAR
#undef PG8_SCHED
}
}

constexpr int NWAVES = 8;
constexpr int N_LAUNCHES = MK_N_LAUNCHES;
constexpr int N_PHASES = 1 + 4 * DEPTH;
static_assert(N_LAUNCHES == 1 || N_LAUNCHES == N_PHASES, "MK_N_LAUNCHES is 1 or 17");

constexpr size_t MiB = 1u << 20;
constexpr size_t WS_CTL = 0, CTL_ZERO_BYTES = 1 * MiB;
constexpr size_t BT1_BYTES = (size_t)N1 * DM * 2, BT2_BYTES = (size_t)DM * K2 * 2, WP_BYTES = (size_t)4 * 256 * 256 * 2;
constexpr size_t WS_BT1 = 2 * MiB, WS_BT2 = WS_BT1 + DEPTH * BT1_BYTES, WS_WP = WS_BT2 + DEPTH * BT2_BYTES;
constexpr size_t WS_XB = WS_WP + DEPTH * WP_BYTES;
constexpr size_t WS_H = WS_XB + (size_t)MTOK * DM * 2;
constexpr size_t WS_AC = WS_H + (size_t)MTOK * N1 * 2;
constexpr size_t WS_Y = WS_AC + (size_t)MTOK * K2 * 2;
constexpr size_t WS_END = WS_Y + (size_t)MTOK * DM * 4;
static_assert(WS_XB % 256 == 0 && WS_H % 256 == 0 && WS_AC % 256 == 0 && WS_Y % 256 == 0, "ws alignment");
constexpr int CW_TMO = 0, CW_CODE = 1, CW_BAR = 4096;

constexpr int RING_BYTES = 131072;
constexpr int LDSCTL_OFF = RING_BYTES, MISC_OFF = LDSCTL_OFF + 320;
constexpr int LDS_BYTES = 147456;

#define GAS __attribute__((address_space(1)))
#define LAS __attribute__((address_space(3)))
typedef unsigned short bf16;
typedef unsigned v4u __attribute__((ext_vector_type(4)));
typedef unsigned v2u __attribute__((ext_vector_type(2)));
typedef float f32x4 __attribute__((ext_vector_type(4)));
typedef GAS unsigned gu32;
#define RLX_AGENT __ATOMIC_RELAXED, __HIP_MEMORY_SCOPE_AGENT
#define LDS_WAIT() asm volatile("s_waitcnt lgkmcnt(0)" ::: "memory")
#define VM_WAIT() asm volatile("s_waitcnt vmcnt(0)" ::: "memory")
__device__ __forceinline__ unsigned f2bf(float f) { unsigned u = __builtin_bit_cast(unsigned, f); return (u + 0x7fffu + ((u >> 16) & 1u)) >> 16; }
__device__ __forceinline__ unsigned pk2(float lo, float hi) { return f2bf(lo) | (f2bf(hi) << 16); }
__device__ __forceinline__ float bfl(unsigned w) { return __uint_as_float(w << 16); }
__device__ __forceinline__ float bfh(unsigned w) { return __uint_as_float(w & 0xffff0000u); }
__device__ __forceinline__ float bf1(bf16 v) { return __uint_as_float((unsigned)v << 16); }

#define XB_TMO      128
#define XB_XCNT(j)  (256  + 64 * (j))
#define XB_XSUB(j)  (1280 + 64 * (j))
#define XB_XGEN(j)  (2304 + 64 * (j))
#define XB_TOP      3328
#define XB_TOPGEN   3392
#define XCD_BAR_WORDS 3456
#define XB_SPIN_CAP (1u << 18)
__device__ __forceinline__ unsigned xb_ld(unsigned* p)              { return __hip_atomic_load(p, __ATOMIC_RELAXED, __HIP_MEMORY_SCOPE_AGENT); }
__device__ __forceinline__ unsigned xb_add(unsigned* p, unsigned v) { return __hip_atomic_fetch_add(p, v, __ATOMIC_RELAXED, __HIP_MEMORY_SCOPE_AGENT); }
__device__ __forceinline__ unsigned xb_xcc_id() { return (unsigned)__builtin_amdgcn_s_getreg((3 << 11) | 20) & 0xFu; }
#define XB_SPIN(cond, bar) do { unsigned _sp = 0; while (cond) { __builtin_amdgcn_s_sleep(1); \
    if ((++_sp & 255u) == 0u) { if (xb_ld(&(bar)[XB_TMO])) break; if (_sp > XB_SPIN_CAP) { atomicAdd(&(bar)[XB_TMO], 1u); break; } } } } while (0)
struct XcdBarrier { unsigned* bar; unsigned x; volatile LAS unsigned* st; };
__device__ __forceinline__ XcdBarrier xcd_barrier_post(unsigned* bar, volatile LAS unsigned* st) {
    XcdBarrier b; b.bar = bar; b.x = xb_xcc_id(); b.st = st;
    if (threadIdx.x == 0) (void)xb_add(&bar[XB_XCNT(b.x)], 1u);
    return b;
}
__device__ __forceinline__ void xcd_barrier_complete(unsigned* bar, unsigned x, unsigned& nloc, unsigned& nx) {
    const unsigned G = gridDim.x * gridDim.y * gridDim.z;
    unsigned sum, cnt, mine, sp = 0u;
    for (;;) {
        sum = 0u; cnt = 0u; mine = 0u;
#pragma unroll
        for (unsigned j = 0; j < 16; ++j) { const unsigned c = xb_ld(&bar[XB_XCNT(j)]); sum += c; cnt += (c > 0u) ? 1u : 0u; mine = (j == x) ? c : mine; }
        if (sum == G) break;
        __builtin_amdgcn_s_sleep(1);
        if ((++sp & 255u) == 0u) { if (xb_ld(&bar[XB_TMO])) break; if (sp > XB_SPIN_CAP) { atomicAdd(&bar[XB_TMO], 1u); break; } }
    }
    nloc = mine > 0u ? mine : 1u; nx = cnt > 0u ? cnt : 1u;
}
__device__ __forceinline__ void xcd_barrier(const XcdBarrier& b) {
    asm volatile("s_waitcnt vmcnt(0)" ::: "memory");
    __syncthreads();
    if (threadIdx.x == 0) {
        unsigned* bar = b.bar;
        __builtin_amdgcn_s_waitcnt(0);
        unsigned nloc = b.st[0], nx = b.st[1];
        if (nloc == 0u) { xcd_barrier_complete(bar, b.x, nloc, nx); b.st[0] = nloc; b.st[1] = nx; }
        const unsigned old = xb_add(&bar[XB_XSUB(b.x)], 1u);
        const unsigned gen = old / nloc;
        if (old + 1u == (gen + 1u) * nloc) {
            __builtin_amdgcn_fence(__ATOMIC_RELEASE, "agent");
            asm volatile("s_waitcnt vmcnt(0)" ::: "memory");
            const unsigned og = xb_add(&bar[XB_TOP], 1u);
            const unsigned tg = og / nx;
            if (og + 1u == (tg + 1u) * nx) xb_add(&bar[XB_TOPGEN], 1u);
            else XB_SPIN(xb_ld(&bar[XB_TOPGEN]) == tg, bar);
            __builtin_amdgcn_fence(__ATOMIC_ACQUIRE, "agent");
            xb_add(&bar[XB_XGEN(b.x)], 1u);
            asm volatile("s_waitcnt vmcnt(0)" ::: "memory");
        } else {
            XB_SPIN(xb_ld(&bar[XB_XGEN(b.x)]) == gen, bar);
            __builtin_amdgcn_fence(__ATOMIC_ACQUIRE, "agent");
            asm volatile("s_waitcnt vmcnt(0)" ::: "memory");
        }
    }
    __syncthreads();
}

__device__ __forceinline__ float wave_sum(float v) {
#pragma unroll
    for (int o = 1; o < 64; o <<= 1) v += __shfl_xor(v, o);
    return v;
}
__device__ __forceinline__ float wave_max(float v) {
#pragma unroll
    for (int o = 1; o < 64; o <<= 1) v = fmaxf(v, __shfl_xor(v, o));
    return v;
}

__device__ __forceinline__ void p0_transpose_item(const float* W, int N, bf16* WT, int ldt, LAS float* scr, int item, int lane) {
    const int nblk = N / 32, kb = item / nblk, nb = item % nblk, k0 = 64 * kb, n0 = 32 * nb;
#pragma unroll 8
    for (int i = 0; i < 32; ++i) { const int kk = 2 * i + (lane >> 5); scr[kk * 33 + (lane & 31)] = W[(size_t)(k0 + kk) * N + n0 + (lane & 31)]; }
    LDS_WAIT(); asm volatile("" ::: "memory");
    const int c = lane & 7;
#pragma unroll
    for (int j = 0; j < 4; ++j) { const int n = (lane >> 3) + 8 * j; const LAS float* s = scr + (8 * c) * 33 + n;
        v4u o; o.x = pk2(s[0 * 33], s[1 * 33]); o.y = pk2(s[2 * 33], s[3 * 33]); o.z = pk2(s[4 * 33], s[5 * 33]); o.w = pk2(s[6 * 33], s[7 * 33]);
        *(GAS v4u*)(WT + (size_t)(n0 + n) * ldt + k0 + 8 * c) = o; }
    LDS_WAIT(); asm volatile("" ::: "memory");
}

struct Args { const float* in[13]; float* out; unsigned char* ws; int ph_lo, ph_hi, li, pad; };
typedef const __attribute__((address_space(4))) Args* KArgs;
struct Ids { int lane, wave, vcu, G, bx; };
__device__ __forceinline__ Ids phase_ids() {
    int tid = threadIdx.x; asm volatile("" : "+v"(tid));
    Ids I; I.lane = tid & 63; I.wave = __builtin_amdgcn_readfirstlane(tid >> 6); I.G = gridDim.x; I.bx = blockIdx.x;
    I.vcu = (I.G % 8 == 0) ? (I.bx % 8) * (I.G / 8) + I.bx / 8 : I.bx; return I;
}

__device__ __forceinline__ void p0_prologue(KArgs ap, LAS unsigned char* lds) {
    const Ids I = phase_ids(); const int vcu = I.vcu, G = I.G, wave = I.wave, lane = I.lane;
    LAS float* scr = (LAS float*)(lds + wave * 16384);
    const int gw = vcu * NWAVES + wave, NGW = G * NWAVES;
    constexpr int I_IN = (DM / 64) * (IN_COLS / 32), I_G = (DM / 64) * (DM / 32), I_PLE = (PLE / 64) * (DM / 32), I_O = I_G, I_POOL = 4 * (256 / 64) * (256 / 32);
    constexpr int I_LAYER = I_IN + I_G + I_PLE + I_O + I_POOL;
    for (int it = gw; it < DEPTH * I_LAYER; it += NGW) {
        const int l = it / I_LAYER; int r = it % I_LAYER;
        bf16* bt1 = (bf16*)(ap->ws + WS_BT1 + (size_t)l * BT1_BYTES); bf16* bt2 = (bf16*)(ap->ws + WS_BT2 + (size_t)l * BT2_BYTES); bf16* wp = (bf16*)(ap->ws + WS_WP + (size_t)l * WP_BYTES);
        if (r < I_IN) { p0_transpose_item(ap->in[2] + (size_t)l * DM * IN_COLS, IN_COLS, bt1, DM, scr, r, lane); continue; } r -= I_IN;
        if (r < I_G) { p0_transpose_item(ap->in[10] + (size_t)l * DM * DM, DM, bt1 + (size_t)IN_COLS * DM, DM, scr, r, lane); continue; } r -= I_G;
        if (r < I_PLE) { p0_transpose_item(ap->in[9] + (size_t)l * PLE * DM, DM, bt2, K2, scr, r, lane); continue; } r -= I_PLE;
        if (r < I_O) { p0_transpose_item(ap->in[4] + (size_t)l * DM * DM, DM, bt2 + PLE, K2, scr, r, lane); continue; } r -= I_O;
        { const int g = r / 32, rr = r % 32; p0_transpose_item(ap->in[7] + ((size_t)l * 4 + g) * 256 * 256, 256, wp + (size_t)g * 256 * 256, 256, scr, rr, lane); }
    }
    const float* x = ap->in[0]; bf16* xb = (bf16*)(ap->ws + WS_XB);
    for (size_t i = (size_t)gw * 64 + lane; i < (size_t)MTOK * DM / 4; i += (size_t)NGW * 64) {
        const f32x4 v = *(const GAS f32x4*)(x + 4 * i); v2u o; o.x = pk2(v.x, v.y); o.y = pk2(v.z, v.w); *(GAS v2u*)(xb + 4 * i) = o; }
}

__device__ __forceinline__ int t5_bucket(int d) {
    if (d < 16) return d;
    const int b = 16 + (int)(__log2f((float)d * 0.0625f) * (16.0f / 3.0f));
    return b < 31 ? b : 31;
}
__device__ __forceinline__ void t_phase_naive(KArgs ap, int l, LAS unsigned char* lds) {
    const Ids I = phase_ids(); const int vcu = I.vcu, G = I.G, wave = I.wave, lane = I.lane;
    const int gw = vcu * NWAVES + wave, NGW = G * NWAVES;
    const bf16* H = (const bf16*)(ap->ws + WS_H); bf16* AC = (bf16*)(ap->ws + WS_AC);
    { const float* p = ap->in[1] + (size_t)l * MTOK * PLE;
      for (int i = gw * 64 + lane; i < MTOK * PLE / 4; i += NGW * 64) { const int row = i >> 6, c4 = i & 63;
          const f32x4 v = *(const GAS f32x4*)(p + (size_t)row * PLE + 4 * c4); v2u o; o.x = pk2(v.x, v.y); o.y = pk2(v.z, v.w);
          *(GAS v2u*)(AC + (size_t)row * LDAC + AC_P + 4 * c4) = o; } }
    const float* sinks = ap->in[5] + l * NHEAD; const float* relb = ap->in[6];
    for (int it = gw; it < MTOK * NHEAD; it += NGW) {
        const int m = it >> 4, h = it & 15, s = m & (SEQ - 1), kvh = h >> 3;
        const bf16* qrow = H + (size_t)m * LDH + HQ + h * HD;
        float sc[2];
#pragma unroll
        for (int part = 0; part < 2; ++part) {
            const int dist = lane + 64 * part; float dot = 0.f;
            if (dist <= s) {
                const bf16* krow = H + (size_t)(m - dist) * LDH + HK + kvh * HD;
#pragma unroll
                for (int c = 0; c < 8; ++c) { const v4u qv = *(const GAS v4u*)(qrow + 8 * c), kv = *(const GAS v4u*)(krow + 8 * c);
                    dot += bfl(qv.x) * bfl(kv.x) + bfh(qv.x) * bfh(kv.x) + bfl(qv.y) * bfl(kv.y) + bfh(qv.y) * bfh(kv.y)
                         + bfl(qv.z) * bfl(kv.z) + bfh(qv.z) * bfh(kv.z) + bfl(qv.w) * bfl(kv.w) + bfh(qv.w) * bfh(kv.w); }
                dot += relb[t5_bucket(dist) * NHEAD + h] * LOG2E;
            } else dot = -1e30f;
            sc[part] = dot;
        }
        const float sink2 = sinks[h] * LOG2E;
        const float mx = fmaxf(wave_max(fmaxf(sc[0], sc[1])), sink2);
        const float e0 = __builtin_amdgcn_exp2f(sc[0] - mx), e1 = __builtin_amdgcn_exp2f(sc[1] - mx);
        const float den = wave_sum(e0 + e1) + __builtin_amdgcn_exp2f(sink2 - mx);
        const float p0 = e0 / den, p1 = e1 / den;
        float o = 0.f;
        const bf16* vcol = H + (size_t)m * LDH + HV + kvh * HD + lane;
        const int nd = s < 127 ? s + 1 : 128;
        for (int d = 0; d < nd; ++d) { const float pd = d < 64 ? __shfl(p0, d) : __shfl(p1, d - 64); o += pd * bf1(*(const GAS bf16*)(vcol - (size_t)d * LDH)); }
        const float ga = bf1(H[(size_t)m * LDH + HGA + h * HD + lane]);
        AC[(size_t)m * LDAC + AC_A + h * HD + lane] = (bf16)f2bf(o * ga);
    }
    LAS float* dsh = (LAS float*)(lds + wave * 1024);
    const float* wpool = ap->in[7] + (size_t)l * 4 * 256 * 256; const float* pscale = ap->in[8] + l * 1024;
    for (int it = gw; it < MTOK * 4; it += NGW) {
        const int m = it >> 2, g = it & 3, s = m & (SEQ - 1), w = 2 << g;
        const bf16* ucol = H + (size_t)m * LDH + HU + g * 256 + 4 * lane;
        float sum[4] = {0.f, 0.f, 0.f, 0.f}, self[4] = {0.f, 0.f, 0.f, 0.f};
        const int cnt = s + 1 < w ? s + 1 : w;
        for (int j = 0; j < cnt; ++j) { const v2u uv = *(const GAS v2u*)(ucol - (size_t)j * LDH);
            const float u0 = bfl(uv.x), u1 = bfh(uv.x), u2 = bfl(uv.y), u3 = bfh(uv.y);
            sum[0] += u0; sum[1] += u1; sum[2] += u2; sum[3] += u3;
            if (j == 0) { self[0] = u0; self[1] = u1; self[2] = u2; self[3] = u3; } }
        const float inv = 1.0f / (float)cnt;
#pragma unroll
        for (int e = 0; e < 4; ++e) dsh[4 * lane + e] = sum[e] * inv - self[e];
        LDS_WAIT(); asm volatile("" ::: "memory");
        const float* wg = wpool + (size_t)g * 256 * 256 + 4 * lane;
        f32x4 acc = (f32x4){0.f, 0.f, 0.f, 0.f};
#pragma unroll 4
        for (int c = 0; c < 256; ++c) { const float dv = dsh[c]; const f32x4 wv = *(const GAS f32x4*)(wg + (size_t)c * 256); acc = acc + wv * dv; }
        LDS_WAIT(); asm volatile("" ::: "memory");
        const f32x4 ps = *(const GAS f32x4*)(pscale + g * 256 + 4 * lane);
        const v2u gv = *(const GAS v2u*)(H + (size_t)m * LDH + HGB + g * 256 + 4 * lane);
        v2u o; o.x = pk2(acc.x * ps.x * bfl(gv.x), acc.y * ps.y * bfh(gv.x)); o.y = pk2(acc.z * ps.z * bfl(gv.y), acc.w * ps.w * bfh(gv.y));
        *(GAS v2u*)(AC + (size_t)m * LDAC + AC_B + g * 256 + 4 * lane) = o;
    }
}

__device__ __forceinline__ void ln_phase(KArgs ap, int l) {
    const Ids I = phase_ids(); const int vcu = I.vcu, G = I.G, wave = I.wave, lane = I.lane;
    const int gw = vcu * NWAVES + wave, NGW = G * NWAVES;
    const float* Y = (const float*)(ap->ws + WS_Y); bf16* xb = (bf16*)(ap->ws + WS_XB);
    const float* gain = ap->in[11] + l * DM; const float* bias = ap->in[12] + l * DM;
    for (int m = gw; m < MTOK; m += NGW) {
        const GAS f32x4* yr = (const GAS f32x4*)(Y + (size_t)m * DM) + lane;
        f32x4 v[8]; float s = 0.f;
#pragma unroll
        for (int j = 0; j < 8; ++j) { v[j] = yr[64 * j]; s += (v[j].x + v[j].y) + (v[j].z + v[j].w); }
        const float mean = wave_sum(s) * (1.f / DM); float s2 = 0.f;
#pragma unroll
        for (int j = 0; j < 8; ++j) { v[j] = v[j] - mean; s2 += (v[j].x * v[j].x + v[j].y * v[j].y) + (v[j].z * v[j].z + v[j].w * v[j].w); }
        const float rstd = 1.f / sqrtf(wave_sum(s2) * (1.f / DM) + LN_EPS);
        GAS f32x4* orow = (GAS f32x4*)(ap->out + (size_t)m * DM) + lane; GAS v2u* brow = (GAS v2u*)(xb + (size_t)m * DM) + lane;
#pragma unroll
        for (int j = 0; j < 8; ++j) { const f32x4 gn = *((const GAS f32x4*)gain + lane + 64 * j), bs = *((const GAS f32x4*)bias + lane + 64 * j);
            const f32x4 o = v[j] * rstd * gn + bs; orow[64 * j] = o; v2u w; w.x = pk2(o.x, o.y); w.y = pk2(o.z, o.w); brow[64 * j] = w; }
    }
}

__global__ void __launch_bounds__(NWAVES * 64, 2) hymba_fwd(Args args_unused) {
    extern __shared__ __attribute__((aligned(16))) unsigned char lds_raw[];
    LAS unsigned char* lds = (LAS unsigned char*)lds_raw;
    volatile LAS unsigned* MISC = (volatile LAS unsigned*)(lds + MISC_OFF);
    const KArgs kp = (KArgs)__builtin_amdgcn_kernarg_segment_ptr();
    for (int u = threadIdx.x; u < (LDS_BYTES - LDSCTL_OFF) / 4; u += NWAVES * 64) ((LAS unsigned*)(lds + LDSCTL_OFF))[u] = 0u;
    __syncthreads();
    XcdBarrier bar; bar.bar = (unsigned*)(kp->ws + WS_CTL) + CW_BAR; bar.x = 0; bar.st = nullptr;
    if (N_LAUNCHES == 1) bar = xcd_barrier_post((unsigned*)(kp->ws + WS_CTL) + CW_BAR, MISC + 8);
#define GRID_BAR() do { if (N_LAUNCHES == 1) xcd_barrier(bar); } while (0)
#define LAUNDER(p) asm volatile("" : "+s"(p))
#define IN(k) (kp->ph_lo <= (k) && (k) < kp->ph_hi)
#define BOTH(k) (IN(k) && IN((k) + 1))

    if ((PH_MASK & 1) && IN(0)) { KArgs a = kp; LAUNDER(a); p0_prologue(a, lds); if (BOTH(0)) GRID_BAR(); }

    for (int l = 0; l < DEPTH; ++l) {
        const int pb = 1 + 4 * l;
        if ((PH_MASK & 2) && IN(pb)) {
            KArgs a = kp; LAUNDER(a); unsigned char* ws = a->ws;
            pg8::Gemm g{(const bf16*)(ws + WS_XB), (const bf16*)(ws + WS_BT1 + (size_t)l * BT1_BYTES), MTOK, N1, DM}; pg8::StaticOrder S; S.init(MTOK, N1, gridDim.x, blockIdx.x);
            pg8::EpiH E{(bf16*)(ws + WS_H), a->in[3] + l * IN_COLS};
            pg8::gemm_phase<pg8::EpiH, pg8::StaticOrder, true>(lds, g, S, E);
            if (BOTH(pb)) GRID_BAR();
        }
        if ((PH_MASK & 4) && IN(pb + 1)) {
            KArgs a = kp; LAUNDER(a);
            t_phase_naive(a, l, lds);
            if (BOTH(pb + 1)) GRID_BAR();
        }
        if ((PH_MASK & 8) && IN(pb + 2)) {
            KArgs a = kp; LAUNDER(a); unsigned char* ws = a->ws;
            pg8::Gemm g{(const bf16*)(ws + WS_AC), (const bf16*)(ws + WS_BT2 + (size_t)l * BT2_BYTES), MTOK, DM, K2}; pg8::StaticOrder S; S.init(MTOK, DM, gridDim.x, blockIdx.x);
            pg8::EpiY E{(const bf16*)(ws + WS_H), l == 0 ? a->in[0] : a->out, (float*)(ws + WS_Y)};
            pg8::gemm_phase<pg8::EpiY, pg8::StaticOrder, false>(lds, g, S, E);
            if (BOTH(pb + 2)) GRID_BAR();
        }
        if ((PH_MASK & 16) && IN(pb + 3)) {
            KArgs a = kp; LAUNDER(a);
            ln_phase(a, l);
            if (BOTH(pb + 3)) GRID_BAR();
        }
    }
#undef IN
#undef BOTH
}

extern "C" void kernel_launch(void* const* d_in, const int* in_sizes, int n_in, void* d_out, int out_size, void* d_ws, size_t ws_size, hipStream_t stream) {
    static int grid = 0;
    if (grid == 0) {
        if (n_in != 13 || in_sizes[0] != MTOK * DM || out_size != MTOK * DM || ws_size < WS_END) {
            fprintf(stderr, "kernel_launch: unexpected shapes: n_in %d in0 %d out %d ws %zu (need %zu)\n", n_in, n_in > 0 ? in_sizes[0] : -1, out_size, ws_size, (size_t)WS_END); grid = -1; return; }
        int dev = 0, cus = 0, per_cu = 0;
        if (hipGetDevice(&dev) != hipSuccess || hipDeviceGetAttribute(&cus, hipDeviceAttributeMultiprocessorCount, dev) != hipSuccess) { grid = -1; return; }
        if (hipFuncSetAttribute((const void*)hymba_fwd, hipFuncAttributeMaxDynamicSharedMemorySize, LDS_BYTES) != hipSuccess) { fprintf(stderr, "kernel_launch: hipFuncSetAttribute failed\n"); grid = -1; return; }
        if (hipOccupancyMaxActiveBlocksPerMultiprocessor(&per_cu, (const void*)hymba_fwd, NWAVES * 64, LDS_BYTES) != hipSuccess || per_cu < 1)
            fprintf(stderr, "kernel_launch: note: occupancy query reports %d workgroups per CU\n", per_cu);
        (void)hipGetLastError();
        grid = cus;
    }
    if (grid < 0) return;
    if (hipMemsetAsync((char*)d_ws + WS_CTL, 0, CTL_ZERO_BYTES, stream) != hipSuccess) return;
    Args a{};
    for (int i = 0; i < 13; ++i) a.in[i] = (const float*)d_in[i];
    a.out = (float*)d_out; a.ws = (unsigned char*)d_ws;
    for (int li = 0; li < N_LAUNCHES; ++li) {
        a.ph_lo = (N_LAUNCHES == 1) ? 0 : li; a.ph_hi = (N_LAUNCHES == 1) ? N_PHASES : li + 1; a.li = li;
        hipLaunchKernelGGL(hymba_fwd, dim3(grid), dim3(NWAVES * 64), LDS_BYTES, stream, a);
        const hipError_t le = hipPeekAtLastError();
        if (le != hipSuccess) { fprintf(stderr, "kernel_launch: launch %d failed: %s\n", li, hipGetErrorName(le)); break; }
    }
}
```

```cpp
#include <hip/hip_runtime.h>
#include <cstdio>
#include <cstdint>

#ifndef MK_N_LAUNCHES
#define MK_N_LAUNCHES 1
#endif
#ifndef PH_MASK
#define PH_MASK 31
#endif
#ifndef T_NAIVE
#define T_NAIVE 0
#endif

constexpr int BATCH = 2, SEQ = 4096, DM = 2048, DEPTH = 4, MTOK = BATCH * SEQ;
constexpr int PLE = 256, NHEAD = 16, HD = 64, NKV = 2, WINDOW = 128;
constexpr int IN_COLS = 4352;
constexpr int N1 = IN_COLS + DM;
constexpr int K2 = PLE + DM;
constexpr int HQ = 0, HK = 1024, HV = 1152, HGA = 1280, HU = 2304, HGB = 3328, HGATE = 4352, LDH = N1;
constexpr int AC_P = 0, AC_A = 256, AC_B = 1280, LDAC = K2;
constexpr float LN_EPS = 1e-5f;
constexpr float ALPHA = 1.6817928305074290f;
constexpr float LOG2E = 1.4426950408889634f;
constexpr float QSCALE = 0.125f * LOG2E;

namespace pg8 {
#define PG8_LAS __attribute__((address_space(3)))
typedef unsigned short bf16_t;
typedef short bf16x8 __attribute__((ext_vector_type(8)));
typedef float f32x4 __attribute__((ext_vector_type(4)));
typedef unsigned u32x4 __attribute__((ext_vector_type(4)));
constexpr int BM = 256, BK = 64, HALF = 128, HTB = HALF * BK * 2, STAGE_BYTES = 8 * HTB, NXCD = 8, WGM = 8;

__host__ __device__ __forceinline__ int lds_byte(int r, int c) { const int st = (r >> 4) * 2 + (c >> 5), rr = r & 15, cc = c & 31, ob = rr * 64 + cc * 2; return st * 1024 + (ob ^ (((ob >> 9) & 1) << 5)); }
__host__ __device__ __forceinline__ void stage_rc(int b, int& R, int& C) { const int st = b / 1024, sb = b % 1024, swz = sb ^ (((sb >> 9) & 1) << 5); R = (st >> 1) * 16 + swz / 64; C = (st & 1) * 32 + (swz % 64) / 2; }
__host__ __device__ __forceinline__ int perm32(int rho) { const int n = rho >> 4, i = rho & 15; return 8 * (i >> 2) + 4 * n + (i & 3); }

struct Unit { int pm, pn; };
struct Gemm { const bf16_t* A; const bf16_t* Bt; int M, N, K; };

struct StaticOrder {
    int nM, nN, nwg, G, c;
    __host__ __device__ void init(int M, int N, int G_, int c_) { nM = M / BM; nN = N / BM; nwg = nM * nN; G = G_; c = c_; }
    __host__ __device__ bool next(int i, Unit& u) const {
        const long L = (long)i * G + c; if (L >= nwg) return false;
        int wgid = (int)L; { const int q = nwg / NXCD, r = nwg % NXCD, xcd = wgid % NXCD, off = wgid / NXCD; wgid = (xcd < r ? xcd * (q + 1) : r * (q + 1) + (xcd - r) * q) + off; }
        const int nig = WGM * nN, gid = wgid / nig, fm = gid * WGM, gsz = (nM - fm) < WGM ? (nM - fm) : WGM;
        u.pm = fm + ((wgid % nig) % gsz); u.pn = (wgid % nig) / gsz; return true;
    }
};

__device__ __forceinline__ unsigned cvt_pk_bf16(float lo, float hi) { unsigned r; asm volatile("v_cvt_pk_bf16_f32 %0, %1, %2" : "=v"(r) : "v"(lo), "v"(hi)); return r; }
__device__ __forceinline__ float bf_lo(unsigned w) { return __uint_as_float(w << 16); }
__device__ __forceinline__ float bf_hi(unsigned w) { return __uint_as_float(w & 0xffff0000u); }
__device__ __forceinline__ float sigmoidf_fast(float v) { return __builtin_amdgcn_rcpf(1.0f + __builtin_amdgcn_exp2f(-LOG2E * v)); }


struct EpiH {
    static constexpr bool PERM = true; static constexpr int HOOK_T = 0;
    bf16_t* H; const float* bias;
    __device__ __forceinline__ void hook(f32x4 (&)[2][2][4][2], const Unit&, int, int, int, int) const {}
    __device__ __forceinline__ void operator()(const f32x4 (&acc)[2][2][4][2], const Unit& u, int wr, int wc, int fr, int fq) const {
        const int row0 = u.pm * BM + wr * 64 + fr, col0 = u.pn * BM + wc * 32 + 8 * fq;
        const int pn = u.pn; const int mode = pn < 4 ? 0 : (pn == 4 ? 1 : (pn < 9 ? 2 : (pn < 13 ? 1 : (pn < 17 ? 2 : 3))));
        f32x4 bv[2][2];
#pragma unroll
        for (int bj = 0; bj < 2; ++bj)
#pragma unroll
            for (int n = 0; n < 2; ++n) bv[bj][n] = (mode != 3) ? *(const f32x4*)(bias + col0 + bj * HALF + 4 * n) : (f32x4){0.f, 0.f, 0.f, 0.f};
#pragma unroll
        for (int ai = 0; ai < 2; ++ai)
#pragma unroll
            for (int m = 0; m < 4; ++m) { bf16_t* rowp = H + (size_t)(row0 + ai * HALF + m * 16) * LDH + col0;
#pragma unroll
                for (int bj = 0; bj < 2; ++bj) { f32x4 v0 = acc[ai][bj][m][0] + bv[bj][0], v1 = acc[ai][bj][m][1] + bv[bj][1];
                    if (mode == 0) { v0 = v0 * QSCALE; v1 = v1 * QSCALE; }
                    else if (mode == 2) {
#pragma unroll
                        for (int e = 0; e < 4; ++e) { v0[e] = v0[e] * sigmoidf_fast(v0[e]); v1[e] = v1[e] * sigmoidf_fast(v1[e]); } }
                    else if (mode == 3) {
#pragma unroll
                        for (int e = 0; e < 4; ++e) { v0[e] = sigmoidf_fast(v0[e]); v1[e] = sigmoidf_fast(v1[e]); } }
                    u32x4 w; w.x = cvt_pk_bf16(v0[0], v0[1]); w.y = cvt_pk_bf16(v0[2], v0[3]); w.z = cvt_pk_bf16(v1[0], v1[1]); w.w = cvt_pk_bf16(v1[2], v1[3]);
                    *(u32x4*)(rowp + bj * HALF) = w; } }
    }
};

struct EpiY {
    static constexpr bool PERM = true; static constexpr int HOOK_T = PLE / BK;
    const bf16_t* H; const float* xres; float* Y;
    __device__ __forceinline__ void hook(f32x4 (&acc)[2][2][4][2], const Unit& u, int wr, int wc, int fr, int fq) const {
        int opq = 0; asm volatile("" : "+v"(opq));
        const int row0 = u.pm * BM + wr * 64 + fr + opq, col0 = u.pn * BM + wc * 32 + 8 * fq;
#pragma unroll
        for (int ai = 0; ai < 2; ++ai)
#pragma unroll
            for (int mp = 0; mp < 2; ++mp) { u32x4 g[2][2];
#pragma unroll
                for (int mm = 0; mm < 2; ++mm)
#pragma unroll
                    for (int bj = 0; bj < 2; ++bj) g[mm][bj] = *(const u32x4*)(H + (size_t)(row0 + ai * HALF + (2 * mp + mm) * 16) * LDH + HGATE + col0 + bj * HALF);
#pragma unroll
                for (int mm = 0; mm < 2; ++mm)
#pragma unroll
                    for (int bj = 0; bj < 2; ++bj) { const int m = 2 * mp + mm; const u32x4 gg = g[mm][bj];
                        acc[ai][bj][m][0] = acc[ai][bj][m][0] * (f32x4){bf_lo(gg.x), bf_hi(gg.x), bf_lo(gg.y), bf_hi(gg.y)};
                        acc[ai][bj][m][1] = acc[ai][bj][m][1] * (f32x4){bf_lo(gg.z), bf_hi(gg.z), bf_lo(gg.w), bf_hi(gg.w)}; }
                asm volatile("" ::: "memory"); }
    }
    __device__ __forceinline__ void operator()(const f32x4 (&acc)[2][2][4][2], const Unit& u, int wr, int wc, int fr, int fq) const {
        const int row0 = u.pm * BM + wr * 64 + fr, col0 = u.pn * BM + wc * 32 + 8 * fq;
#pragma unroll
        for (int ai = 0; ai < 2; ++ai)
#pragma unroll
            for (int mp = 0; mp < 2; ++mp) { f32x4 xr[2][2][2];
#pragma unroll
                for (int mm = 0; mm < 2; ++mm)
#pragma unroll
                    for (int bj = 0; bj < 2; ++bj)
#pragma unroll
                        for (int n = 0; n < 2; ++n) xr[mm][bj][n] = *(const f32x4*)(xres + (size_t)(row0 + ai * HALF + (2 * mp + mm) * 16) * DM + col0 + bj * HALF + 4 * n);
#pragma unroll
                for (int mm = 0; mm < 2; ++mm)
#pragma unroll
                    for (int bj = 0; bj < 2; ++bj)
#pragma unroll
                        for (int n = 0; n < 2; ++n) *(f32x4*)(Y + (size_t)(row0 + ai * HALF + (2 * mp + mm) * 16) * DM + col0 + bj * HALF + 4 * n) = xr[mm][bj][n] * ALPHA + acc[ai][bj][2 * mp + mm][n];
                asm volatile("" ::: "memory"); }
    }
};

template <class Epi, class Sched, bool ALIGN_EPI>
__device__ __forceinline__ void gemm_phase(PG8_LAS unsigned char* lds, const Gemm g, const Sched& S, const Epi& E) {
    int tid_ = threadIdx.x; asm volatile("" : "+v"(tid_));
    const int tid = tid_, wid = __builtin_amdgcn_readfirstlane(tid >> 6), lane = tid & 63, wr = wid >> 2, wc = wid & 3, fr = lane & 15, fq = lane >> 4;
    const int K = g.K, nt = K / BK;
    unsigned voffA[2], voffB[2];
#pragma unroll
    for (int i = 0; i < 2; ++i) { int R, C; stage_rc(tid * 16 + i * 8192, R, C); const int Rb = Epi::PERM ? ((R & ~31) + perm32(R & 31)) : R;
        voffA[i] = (unsigned)(R * K + C) * 2u; voffB[i] = (unsigned)(Rb * K + C) * 2u; }
    const size_t kstep = (size_t)(BK * 2);
    const size_t hstep = (size_t)HALF * K * 2;
    const size_t tstep = 2 * hstep;
    const unsigned ldsw = (unsigned)wid * 1024u;
    const int aoff = lds_byte(wr * 64 + fr, fq * 8), boff = lds_byte(wc * 32 + fr, fq * 8);
#define PG8_SA(b, h) (((b) * 2 + (h)) * HTB)
#define PG8_SB(b, h) ((4 + (b) * 2 + (h)) * HTB)
#define PG8_STAGE(bufoff, gbase, voff) do { _Pragma("unroll") for (int _i = 0; _i < 2; ++_i) \
        __builtin_amdgcn_global_load_lds((const unsigned*)((const char*)(gbase) + (voff)[_i]), (PG8_LAS unsigned*)(lds + (bufoff) + ldsw + _i * 8192), 16, 0, 0); } while (0)
#define PG8_LDA(dst, b, h) do { _Pragma("unroll") for (int m = 0; m < 4; ++m) _Pragma("unroll") for (int k = 0; k < 2; ++k) dst[m][k] = *(const PG8_LAS bf16x8*)(lds + PG8_SA(b, h) + aoff + m * 2048 + k * 1024); } while (0)
#define PG8_LDB(dst, b, h) do { _Pragma("unroll") for (int n = 0; n < 2; ++n) _Pragma("unroll") for (int k = 0; k < 2; ++k) dst[n][k] = *(const PG8_LAS bf16x8*)(lds + PG8_SB(b, h) + boff + n * 2048 + k * 1024); } while (0)
#define PG8_MMA(ai, bj, At, Bt) do { __builtin_amdgcn_s_setprio(1); _Pragma("unroll") for (int m = 0; m < 4; ++m) _Pragma("unroll") for (int n = 0; n < 2; ++n) _Pragma("unroll") for (int k = 0; k < 2; ++k) \
        acc[ai][bj][m][n] = __builtin_amdgcn_mfma_f32_16x16x32_bf16(Bt[n][k], At[m][k], acc[ai][bj][m][n], 0, 0, 0); __builtin_amdgcn_s_setprio(0); } while (0)
#define PG8_WAIT_V(n) asm volatile("s_waitcnt vmcnt(" #n ")" ::: "memory")
#define PG8_WAIT_L(n) asm volatile("s_waitcnt lgkmcnt(" #n ")" ::: "memory")
#define PG8_BAR __builtin_amdgcn_s_barrier()
#define PG8_SCHED __builtin_amdgcn_sched_barrier(0)
    Unit cur, nxt; int ui = 0;
    if (!S.next(0, cur)) return;
    f32x4 acc[2][2][4][2];
#pragma unroll
    for (int a = 0; a < 2; ++a)
#pragma unroll
        for (int b = 0; b < 2; ++b)
#pragma unroll
            for (int m = 0; m < 4; ++m)
#pragma unroll
                for (int n = 0; n < 2; ++n) acc[a][b][m][n] = (f32x4){0.f, 0.f, 0.f, 0.f};
    bf16x8 At[4][2], B0[2][2], B1[2][2];
    const char* cA = (const char*)g.A + (size_t)cur.pm * tstep; const char* cB = (const char*)g.Bt + (size_t)cur.pn * tstep;
    PG8_STAGE(PG8_SB(0, 0), cB, voffB); PG8_STAGE(PG8_SB(0, 1), cB + hstep, voffB); PG8_STAGE(PG8_SA(0, 0), cA, voffA); PG8_STAGE(PG8_SA(0, 1), cA + hstep, voffA);
    if (wr == 1) PG8_BAR;
    PG8_WAIT_V(2); PG8_BAR;
    PG8_STAGE(PG8_SB(1, 0), cB + kstep, voffB); PG8_STAGE(PG8_SA(1, 0), cA + kstep, voffA); PG8_STAGE(PG8_SB(1, 1), cB + hstep + kstep, voffB);
    PG8_WAIT_V(6); PG8_BAR;
    for (;;) {
        const bool has_next = S.next(ui + 1, nxt);
        const char* nA = has_next ? (const char*)g.A + (size_t)nxt.pm * tstep : cA; const char* nB = has_next ? (const char*)g.Bt + (size_t)nxt.pn * tstep : cB;
        for (int t = 0; t < nt; t += 2) {
            if (Epi::HOOK_T > 0 && t == Epi::HOOK_T) E.hook(acc, cur, wr, wc, fr, fq);
            const bool last = (t == nt - 2);
            const char* a1 = cA + (size_t)(t + 1) * kstep;
            const char* a2 = last ? nA : cA + (size_t)(t + 2) * kstep; const char* b2 = last ? nB : cB + (size_t)(t + 2) * kstep;
            const char* a3 = a2 + kstep; const char* b3 = b2 + kstep;
            PG8_LDB(B0, 0, 0); PG8_LDB(B1, 0, 1); PG8_SCHED; PG8_LDA(At, 0, 0); PG8_STAGE(PG8_SA(1, 1), a1 + hstep, voffA);
            PG8_WAIT_V(8); PG8_WAIT_L(0); PG8_BAR; PG8_MMA(0, 0, At, B0); PG8_MMA(0, 1, At, B1); PG8_BAR; PG8_SCHED;
            PG8_LDA(At, 0, 1); PG8_STAGE(PG8_SB(0, 0), b2, voffB); PG8_STAGE(PG8_SB(0, 1), b2 + hstep, voffB); PG8_STAGE(PG8_SA(0, 0), a2, voffA);
            PG8_WAIT_V(8); PG8_WAIT_L(0); PG8_BAR; PG8_MMA(1, 0, At, B0); PG8_MMA(1, 1, At, B1); PG8_BAR; PG8_SCHED;
            PG8_LDB(B0, 1, 0); PG8_LDB(B1, 1, 1); PG8_SCHED; PG8_LDA(At, 1, 0); PG8_STAGE(PG8_SA(0, 1), a2 + hstep, voffA);
            PG8_WAIT_V(8); PG8_WAIT_L(0); PG8_BAR; PG8_MMA(0, 0, At, B0); PG8_MMA(0, 1, At, B1); PG8_BAR; PG8_SCHED;
            PG8_LDA(At, 1, 1); PG8_STAGE(PG8_SB(1, 0), b3, voffB); PG8_STAGE(PG8_SB(1, 1), b3 + hstep, voffB); PG8_STAGE(PG8_SA(1, 0), a3, voffA);
            PG8_WAIT_V(8); PG8_WAIT_L(0); PG8_BAR; PG8_MMA(1, 0, At, B0); PG8_MMA(1, 1, At, B1); PG8_BAR; PG8_SCHED;
        }
        if constexpr (ALIGN_EPI) { if (wr == 0) PG8_BAR; }
        E(acc, cur, wr, wc, fr, fq);
        if (!has_next) break;
#pragma unroll
        for (int a = 0; a < 2; ++a)
#pragma unroll
            for (int b = 0; b < 2; ++b)
#pragma unroll
                for (int m = 0; m < 4; ++m)
#pragma unroll
                    for (int n = 0; n < 2; ++n) acc[a][b][m][n] = (f32x4){0.f, 0.f, 0.f, 0.f};
        cur = nxt; cA = nA; cB = nB; ++ui;
        if constexpr (ALIGN_EPI) { if (wr == 1) PG8_BAR; }
    }
    PG8_WAIT_V(0);
    if constexpr (!ALIGN_EPI) { if (wr == 0) PG8_BAR; }
    PG8_BAR;
#undef PG8_SA
#undef PG8_SB
#undef PG8_STAGE
#undef PG8_LDA
#undef PG8_LDB
#undef PG8_MMA
#undef PG8_WAIT_V
#undef PG8_WAIT_L
#undef PG8_BAR
#undef PG8_SCHED
}
}

constexpr int NWAVES = 8;
constexpr int N_LAUNCHES = MK_N_LAUNCHES;
constexpr int N_PHASES = 1 + 4 * DEPTH;
static_assert(N_LAUNCHES == 1 || N_LAUNCHES == N_PHASES, "MK_N_LAUNCHES is 1 or 17");

constexpr size_t MiB = 1u << 20;
constexpr size_t WS_CTL = 0, CTL_ZERO_BYTES = 1 * MiB;
constexpr size_t BT1_BYTES = (size_t)N1 * DM * 2, BT2_BYTES = (size_t)DM * K2 * 2, WP_BYTES = (size_t)4 * 256 * 256 * 2;
constexpr size_t WS_BT1 = 2 * MiB, WS_BT2 = WS_BT1 + DEPTH * BT1_BYTES, WS_WP = WS_BT2 + DEPTH * BT2_BYTES;
constexpr size_t WS_XB = WS_WP + DEPTH * WP_BYTES;
constexpr size_t WS_H = WS_XB + (size_t)MTOK * DM * 2;
constexpr size_t WS_AC = WS_H + (size_t)MTOK * N1 * 2;
constexpr size_t WS_Y = WS_AC + (size_t)MTOK * K2 * 2;
constexpr size_t WS_END = WS_Y + (size_t)MTOK * DM * 4;
static_assert(WS_XB % 256 == 0 && WS_H % 256 == 0 && WS_AC % 256 == 0 && WS_Y % 256 == 0, "ws alignment");
constexpr int CW_TMO = 0, CW_CODE = 1, CW_BAR = 4096;

constexpr int RING_BYTES = 131072;
constexpr int LDSCTL_OFF = RING_BYTES, MISC_OFF = LDSCTL_OFF + 320;
constexpr int LDS_BYTES = 147456;

#define GAS __attribute__((address_space(1)))
#define LAS __attribute__((address_space(3)))
typedef unsigned short bf16;
typedef unsigned v4u __attribute__((ext_vector_type(4)));
typedef unsigned v2u __attribute__((ext_vector_type(2)));
typedef float f32x4 __attribute__((ext_vector_type(4)));
typedef GAS unsigned gu32;
#define RLX_AGENT __ATOMIC_RELAXED, __HIP_MEMORY_SCOPE_AGENT
#define LDS_WAIT() asm volatile("s_waitcnt lgkmcnt(0)" ::: "memory")
#define VM_WAIT() asm volatile("s_waitcnt vmcnt(0)" ::: "memory")
__device__ __forceinline__ unsigned f2bf(float f) { unsigned u = __builtin_bit_cast(unsigned, f); return (u + 0x7fffu + ((u >> 16) & 1u)) >> 16; }
__device__ __forceinline__ unsigned pk2(float lo, float hi) { return f2bf(lo) | (f2bf(hi) << 16); }
__device__ __forceinline__ float bfl(unsigned w) { return __uint_as_float(w << 16); }
__device__ __forceinline__ float bfh(unsigned w) { return __uint_as_float(w & 0xffff0000u); }
__device__ __forceinline__ float bf1(bf16 v) { return __uint_as_float((unsigned)v << 16); }

#define XB_TMO      128
#define XB_XCNT(j)  (256  + 64 * (j))
#define XB_XSUB(j)  (1280 + 64 * (j))
#define XB_XGEN(j)  (2304 + 64 * (j))
#define XB_TOP      3328
#define XB_TOPGEN   3392
#define XCD_BAR_WORDS 3456
#define XB_SPIN_CAP (1u << 18)
__device__ __forceinline__ unsigned xb_ld(unsigned* p)              { return __hip_atomic_load(p, __ATOMIC_RELAXED, __HIP_MEMORY_SCOPE_AGENT); }
__device__ __forceinline__ unsigned xb_add(unsigned* p, unsigned v) { return __hip_atomic_fetch_add(p, v, __ATOMIC_RELAXED, __HIP_MEMORY_SCOPE_AGENT); }
__device__ __forceinline__ unsigned xb_xcc_id() { return (unsigned)__builtin_amdgcn_s_getreg((3 << 11) | 20) & 0xFu; }
#define XB_SPIN(cond, bar) do { unsigned _sp = 0; while (cond) { __builtin_amdgcn_s_sleep(1); \
    if ((++_sp & 255u) == 0u) { if (xb_ld(&(bar)[XB_TMO])) break; if (_sp > XB_SPIN_CAP) { atomicAdd(&(bar)[XB_TMO], 1u); break; } } } } while (0)
struct XcdBarrier { unsigned* bar; unsigned x; volatile LAS unsigned* st; };
__device__ __forceinline__ XcdBarrier xcd_barrier_post(unsigned* bar, volatile LAS unsigned* st) {
    XcdBarrier b; b.bar = bar; b.x = xb_xcc_id(); b.st = st;
    if (threadIdx.x == 0) (void)xb_add(&bar[XB_XCNT(b.x)], 1u);
    return b;
}
__device__ __forceinline__ void xcd_barrier_complete(unsigned* bar, unsigned x, unsigned& nloc, unsigned& nx) {
    const unsigned G = gridDim.x * gridDim.y * gridDim.z;
    unsigned sum, cnt, mine, sp = 0u;
    for (;;) {
        sum = 0u; cnt = 0u; mine = 0u;
#pragma unroll
        for (unsigned j = 0; j < 16; ++j) { const unsigned c = xb_ld(&bar[XB_XCNT(j)]); sum += c; cnt += (c > 0u) ? 1u : 0u; mine = (j == x) ? c : mine; }
        if (sum == G) break;
        __builtin_amdgcn_s_sleep(1);
        if ((++sp & 255u) == 0u) { if (xb_ld(&bar[XB_TMO])) break; if (sp > XB_SPIN_CAP) { atomicAdd(&bar[XB_TMO], 1u); break; } }
    }
    nloc = mine > 0u ? mine : 1u; nx = cnt > 0u ? cnt : 1u;
}
__device__ __forceinline__ void xcd_barrier(const XcdBarrier& b) {
    asm volatile("s_waitcnt vmcnt(0)" ::: "memory");
    __syncthreads();
    if (threadIdx.x == 0) {
        unsigned* bar = b.bar;
        __builtin_amdgcn_s_waitcnt(0);
        unsigned nloc = b.st[0], nx = b.st[1];
        if (nloc == 0u) { xcd_barrier_complete(bar, b.x, nloc, nx); b.st[0] = nloc; b.st[1] = nx; }
        const unsigned old = xb_add(&bar[XB_XSUB(b.x)], 1u);
        const unsigned gen = old / nloc;
        if (old + 1u == (gen + 1u) * nloc) {
            __builtin_amdgcn_fence(__ATOMIC_RELEASE, "agent");
            asm volatile("s_waitcnt vmcnt(0)" ::: "memory");
            const unsigned og = xb_add(&bar[XB_TOP], 1u);
            const unsigned tg = og / nx;
            if (og + 1u == (tg + 1u) * nx) xb_add(&bar[XB_TOPGEN], 1u);
            else XB_SPIN(xb_ld(&bar[XB_TOPGEN]) == tg, bar);
            __builtin_amdgcn_fence(__ATOMIC_ACQUIRE, "agent");
            xb_add(&bar[XB_XGEN(b.x)], 1u);
            asm volatile("s_waitcnt vmcnt(0)" ::: "memory");
        } else {
            XB_SPIN(xb_ld(&bar[XB_XGEN(b.x)]) == gen, bar);
            __builtin_amdgcn_fence(__ATOMIC_ACQUIRE, "agent");
            asm volatile("s_waitcnt vmcnt(0)" ::: "memory");
        }
    }
    __syncthreads();
}

__device__ __forceinline__ float wave_sum(float v) {
#pragma unroll
    for (int o = 1; o < 64; o <<= 1) v += __shfl_xor(v, o);
    return v;
}
__device__ __forceinline__ float wave_max(float v) {
#pragma unroll
    for (int o = 1; o < 64; o <<= 1) v = fmaxf(v, __shfl_xor(v, o));
    return v;
}

__device__ __forceinline__ void p0_transpose_item(const float* W, int N, bf16* WT, int ldt, LAS float* scr, int item, int lane) {
    const int nblk = N / 32, kb = item / nblk, nb = item % nblk, k0 = 64 * kb, n0 = 32 * nb;
#pragma unroll 8
    for (int i = 0; i < 32; ++i) { const int kk = 2 * i + (lane >> 5); scr[kk * 33 + (lane & 31)] = W[(size_t)(k0 + kk) * N + n0 + (lane & 31)]; }
    LDS_WAIT(); asm volatile("" ::: "memory");
    const int c = lane & 7;
#pragma unroll
    for (int j = 0; j < 4; ++j) { const int n = (lane >> 3) + 8 * j; const LAS float* s = scr + (8 * c) * 33 + n;
        v4u o; o.x = pk2(s[0 * 33], s[1 * 33]); o.y = pk2(s[2 * 33], s[3 * 33]); o.z = pk2(s[4 * 33], s[5 * 33]); o.w = pk2(s[6 * 33], s[7 * 33]);
        *(GAS v4u*)(WT + (size_t)(n0 + n) * ldt + k0 + 8 * c) = o; }
    LDS_WAIT(); asm volatile("" ::: "memory");
}

struct Args { const float* in[13]; float* out; unsigned char* ws; int ph_lo, ph_hi, li, pad; };
typedef const __attribute__((address_space(4))) Args* KArgs;
struct Ids { int lane, wave, vcu, G, bx; };
__device__ __forceinline__ Ids phase_ids() {
    int tid = threadIdx.x; asm volatile("" : "+v"(tid));
    Ids I; I.lane = tid & 63; I.wave = __builtin_amdgcn_readfirstlane(tid >> 6); I.G = gridDim.x; I.bx = blockIdx.x;
    I.vcu = (I.G % 8 == 0) ? (I.bx % 8) * (I.G / 8) + I.bx / 8 : I.bx; return I;
}

__device__ __forceinline__ void p0_prologue(KArgs ap, LAS unsigned char* lds) {
    const Ids I = phase_ids(); const int vcu = I.vcu, G = I.G, wave = I.wave, lane = I.lane;
    LAS float* scr = (LAS float*)(lds + wave * 16384);
    const int gw = vcu * NWAVES + wave, NGW = G * NWAVES;
    constexpr int I_IN = (DM / 64) * (IN_COLS / 32), I_G = (DM / 64) * (DM / 32), I_PLE = (PLE / 64) * (DM / 32), I_O = I_G, I_POOL = 4 * (256 / 64) * (256 / 32);
    constexpr int I_LAYER = I_IN + I_G + I_PLE + I_O + I_POOL;
    for (int it = gw; it < DEPTH * I_LAYER; it += NGW) {
        const int l = it / I_LAYER; int r = it % I_LAYER;
        bf16* bt1 = (bf16*)(ap->ws + WS_BT1 + (size_t)l * BT1_BYTES); bf16* bt2 = (bf16*)(ap->ws + WS_BT2 + (size_t)l * BT2_BYTES); bf16* wp = (bf16*)(ap->ws + WS_WP + (size_t)l * WP_BYTES);
        if (r < I_IN) { p0_transpose_item(ap->in[2] + (size_t)l * DM * IN_COLS, IN_COLS, bt1, DM, scr, r, lane); continue; } r -= I_IN;
        if (r < I_G) { p0_transpose_item(ap->in[10] + (size_t)l * DM * DM, DM, bt1 + (size_t)IN_COLS * DM, DM, scr, r, lane); continue; } r -= I_G;
        if (r < I_PLE) { p0_transpose_item(ap->in[9] + (size_t)l * PLE * DM, DM, bt2, K2, scr, r, lane); continue; } r -= I_PLE;
        if (r < I_O) { p0_transpose_item(ap->in[4] + (size_t)l * DM * DM, DM, bt2 + PLE, K2, scr, r, lane); continue; } r -= I_O;
        { const int g = r / 32, rr = r % 32; p0_transpose_item(ap->in[7] + ((size_t)l * 4 + g) * 256 * 256, 256, wp + (size_t)g * 256 * 256, 256, scr, rr, lane); }
    }
    const float* x = ap->in[0]; bf16* xb = (bf16*)(ap->ws + WS_XB);
    for (size_t i = (size_t)gw * 64 + lane; i < (size_t)MTOK * DM / 4; i += (size_t)NGW * 64) {
        const f32x4 v = *(const GAS f32x4*)(x + 4 * i); v2u o; o.x = pk2(v.x, v.y); o.y = pk2(v.z, v.w); *(GAS v2u*)(xb + 4 * i) = o; }
}

__device__ __forceinline__ int t5_bucket(int d) {
    if (d < 16) return d;
    const int b = 16 + (int)(__log2f((float)d * 0.0625f) * (16.0f / 3.0f));
    return b < 31 ? b : 31;
}
__device__ __forceinline__ void t_phase_naive(KArgs ap, int l, LAS unsigned char* lds) {
    const Ids I = phase_ids(); const int vcu = I.vcu, G = I.G, wave = I.wave, lane = I.lane;
    const int gw = vcu * NWAVES + wave, NGW = G * NWAVES;
    const bf16* H = (const bf16*)(ap->ws + WS_H); bf16* AC = (bf16*)(ap->ws + WS_AC);
    { const float* p = ap->in[1] + (size_t)l * MTOK * PLE;
      for (int i = gw * 64 + lane; i < MTOK * PLE / 4; i += NGW * 64) { const int row = i >> 6, c4 = i & 63;
          const f32x4 v = *(const GAS f32x4*)(p + (size_t)row * PLE + 4 * c4); v2u o; o.x = pk2(v.x, v.y); o.y = pk2(v.z, v.w);
          *(GAS v2u*)(AC + (size_t)row * LDAC + AC_P + 4 * c4) = o; } }
    const float* sinks = ap->in[5] + l * NHEAD; const float* relb = ap->in[6];
    for (int it = gw; it < MTOK * NHEAD; it += NGW) {
        const int m = it >> 4, h = it & 15, s = m & (SEQ - 1), kvh = h >> 3;
        const bf16* qrow = H + (size_t)m * LDH + HQ + h * HD;
        float sc[2];
#pragma unroll
        for (int part = 0; part < 2; ++part) {
            const int dist = lane + 64 * part; float dot = 0.f;
            if (dist <= s) {
                const bf16* krow = H + (size_t)(m - dist) * LDH + HK + kvh * HD;
#pragma unroll
                for (int c = 0; c < 8; ++c) { const v4u qv = *(const GAS v4u*)(qrow + 8 * c), kv = *(const GAS v4u*)(krow + 8 * c);
                    dot += bfl(qv.x) * bfl(kv.x) + bfh(qv.x) * bfh(kv.x) + bfl(qv.y) * bfl(kv.y) + bfh(qv.y) * bfh(kv.y)
                         + bfl(qv.z) * bfl(kv.z) + bfh(qv.z) * bfh(kv.z) + bfl(qv.w) * bfl(kv.w) + bfh(qv.w) * bfh(kv.w); }
                dot += relb[t5_bucket(dist) * NHEAD + h] * LOG2E;
            } else dot = -1e30f;
            sc[part] = dot;
        }
        const float sink2 = sinks[h] * LOG2E;
        const float mx = fmaxf(wave_max(fmaxf(sc[0], sc[1])), sink2);
        const float e0 = __builtin_amdgcn_exp2f(sc[0] - mx), e1 = __builtin_amdgcn_exp2f(sc[1] - mx);
        const float den = wave_sum(e0 + e1) + __builtin_amdgcn_exp2f(sink2 - mx);
        const float p0 = e0 / den, p1 = e1 / den;
        float o = 0.f;
        const bf16* vcol = H + (size_t)m * LDH + HV + kvh * HD + lane;
        const int nd = s < 127 ? s + 1 : 128;
        for (int d = 0; d < nd; ++d) { const float pd = d < 64 ? __shfl(p0, d) : __shfl(p1, d - 64); o += pd * bf1(*(const GAS bf16*)(vcol - (size_t)d * LDH)); }
        const float ga = bf1(H[(size_t)m * LDH + HGA + h * HD + lane]);
        AC[(size_t)m * LDAC + AC_A + h * HD + lane] = (bf16)f2bf(o * ga);
    }
    LAS float* dsh = (LAS float*)(lds + wave * 1024);
    const float* wpool = ap->in[7] + (size_t)l * 4 * 256 * 256; const float* pscale = ap->in[8] + l * 1024;
    for (int it = gw; it < MTOK * 4; it += NGW) {
        const int m = it >> 2, g = it & 3, s = m & (SEQ - 1), w = 2 << g;
        const bf16* ucol = H + (size_t)m * LDH + HU + g * 256 + 4 * lane;
        float sum[4] = {0.f, 0.f, 0.f, 0.f}, self[4] = {0.f, 0.f, 0.f, 0.f};
        const int cnt = s + 1 < w ? s + 1 : w;
        for (int j = 0; j < cnt; ++j) { const v2u uv = *(const GAS v2u*)(ucol - (size_t)j * LDH);
            const float u0 = bfl(uv.x), u1 = bfh(uv.x), u2 = bfl(uv.y), u3 = bfh(uv.y);
            sum[0] += u0; sum[1] += u1; sum[2] += u2; sum[3] += u3;
            if (j == 0) { self[0] = u0; self[1] = u1; self[2] = u2; self[3] = u3; } }
        const float inv = 1.0f / (float)cnt;
#pragma unroll
        for (int e = 0; e < 4; ++e) dsh[4 * lane + e] = sum[e] * inv - self[e];
        LDS_WAIT(); asm volatile("" ::: "memory");
        const float* wg = wpool + (size_t)g * 256 * 256 + 4 * lane;
        f32x4 acc = (f32x4){0.f, 0.f, 0.f, 0.f};
#pragma unroll 4
        for (int c = 0; c < 256; ++c) { const float dv = dsh[c]; const f32x4 wv = *(const GAS f32x4*)(wg + (size_t)c * 256); acc = acc + wv * dv; }
        LDS_WAIT(); asm volatile("" ::: "memory");
        const f32x4 ps = *(const GAS f32x4*)(pscale + g * 256 + 4 * lane);
        const v2u gv = *(const GAS v2u*)(H + (size_t)m * LDH + HGB + g * 256 + 4 * lane);
        v2u o; o.x = pk2(acc.x * ps.x * bfl(gv.x), acc.y * ps.y * bfh(gv.x)); o.y = pk2(acc.z * ps.z * bfl(gv.y), acc.w * ps.w * bfh(gv.y));
        *(GAS v2u*)(AC + (size_t)m * LDAC + AC_B + g * 256 + 4 * lane) = o;
    }
}

typedef short bf16x8 __attribute__((ext_vector_type(8)));
typedef float f32x16 __attribute__((ext_vector_type(16)));
__device__ __forceinline__ int crow(int r, int h) { return (r & 3) + 8 * (r >> 2) + 4 * h; }
constexpr int T_KL = 0, KL_STRIDE = 144;
constexpr int T_VT = 36864, VT_STRIDE = 520;
constexpr int T_BT = 70144;
constexpr int T_ST = 72192, ST_WAVE = 4608, ST_LD = 36;
constexpr int T_DL = 0, DL_STRIDE = 528;
static_assert(T_VT == 256 * KL_STRIDE && T_BT == T_VT + 64 * VT_STRIDE && T_ST == T_BT + 2048 && T_ST + 8 * ST_WAVE <= RING_BYTES && 128 * DL_STRIDE <= T_ST, "mixer LDS map");

__device__ __forceinline__ void stage_tile(const f32x16& acc, LAS float* st, int lane, float (&o)[16]) {
    const int c = lane & 31, h = lane >> 5;
#pragma unroll
    for (int r = 0; r < 16; ++r) st[crow(r, h) * ST_LD + c] = acc[r];
    LDS_WAIT(); asm volatile("" ::: "memory");
    const LAS f32x4* rp = (const LAS f32x4*)(st + (lane >> 1) * ST_LD + 16 * (lane & 1));
#pragma unroll
    for (int i = 0; i < 4; ++i) { const f32x4 v = rp[i]; o[4 * i] = v.x; o[4 * i + 1] = v.y; o[4 * i + 2] = v.z; o[4 * i + 3] = v.w; }
    LDS_WAIT(); asm volatile("" ::: "memory");
}
__device__ __forceinline__ void gate_store16(const float (&o)[16], const bf16* gp, bf16* op) {
    const v4u g0 = *(const GAS v4u*)gp, g1 = *(const GAS v4u*)(gp + 8);
    v4u w0, w1;
    w0.x = pk2(o[0] * bfl(g0.x), o[1] * bfh(g0.x)); w0.y = pk2(o[2] * bfl(g0.y), o[3] * bfh(g0.y)); w0.z = pk2(o[4] * bfl(g0.z), o[5] * bfh(g0.z)); w0.w = pk2(o[6] * bfl(g0.w), o[7] * bfh(g0.w));
    w1.x = pk2(o[8] * bfl(g1.x), o[9] * bfh(g1.x)); w1.y = pk2(o[10] * bfl(g1.y), o[11] * bfh(g1.y)); w1.z = pk2(o[12] * bfl(g1.z), o[13] * bfh(g1.z)); w1.w = pk2(o[14] * bfl(g1.w), o[15] * bfh(g1.w));
    *(GAS v4u*)op = w0; *(GAS v4u*)(op + 8) = w1;
}

__device__ __forceinline__ void attn_unit(KArgs ap, int l, LAS unsigned char* lds, int au, int tid, int wave, int lane) {
    const bf16* H = (const bf16*)(ap->ws + WS_H); bf16* AC = (bf16*)(ap->ws + WS_AC);
    const int b = au >> 7, rem = au & 127, qb = rem >> 2, kvh = (rem >> 1) & 1, hq = rem & 1;
    const int key0 = qb * 128 - 128;
#pragma unroll
    for (int i = 0; i < 4; ++i) { const int c = tid + 512 * i, key = c >> 3, ch = c & 7, kpos = key0 + key;
        v4u kv = (v4u){0u, 0u, 0u, 0u}, vv = (v4u){0u, 0u, 0u, 0u};
        if (kpos >= 0) { const bf16* rp = H + (size_t)(b * SEQ + kpos) * LDH + kvh * HD + ch * 8; kv = *(const GAS v4u*)(rp + HK); vv = *(const GAS v4u*)(rp + HV); }
        *(LAS v4u*)(lds + T_KL + key * KL_STRIDE + ch * 16) = kv;
        LAS unsigned short* vt = (LAS unsigned short*)(lds + T_VT + (ch * 8) * VT_STRIDE + key * 2);
        vt[0 * (VT_STRIDE / 2)] = (unsigned short)(vv.x & 0xffffu); vt[1 * (VT_STRIDE / 2)] = (unsigned short)(vv.x >> 16);
        vt[2 * (VT_STRIDE / 2)] = (unsigned short)(vv.y & 0xffffu); vt[3 * (VT_STRIDE / 2)] = (unsigned short)(vv.y >> 16);
        vt[4 * (VT_STRIDE / 2)] = (unsigned short)(vv.z & 0xffffu); vt[5 * (VT_STRIDE / 2)] = (unsigned short)(vv.z >> 16);
        vt[6 * (VT_STRIDE / 2)] = (unsigned short)(vv.w & 0xffffu); vt[7 * (VT_STRIDE / 2)] = (unsigned short)(vv.w >> 16); }
    { const int hl = tid >> 7, dist = tid & 127; ((LAS float*)(lds + T_BT))[tid] = ap->in[6][t5_bucket(dist) * NHEAD + kvh * 8 + hq * 4 + hl] * LOG2E; }
    __syncthreads();
    const int rg = wave & 3, hp = wave >> 2, ql = lane & 31, h = lane >> 5;
    const int r0 = qb * 128 + rg * 32;
    const size_t tokrow = (size_t)(b * SEQ + r0);
    LAS float* st = (LAS float*)(lds + T_ST + wave * ST_WAVE);
    const LAS float* bt = (const LAS float*)(lds + T_BT);
    for (int it = 0; it < 2; ++it) {
        const int hl = hp * 2 + it, head = kvh * 8 + hq * 4 + hl;
        bf16x8 qf[4];
#pragma unroll
        for (int s = 0; s < 4; ++s) qf[s] = *(const GAS bf16x8*)(H + (tokrow + ql) * LDH + HQ + head * HD + 16 * s + 8 * h);
        f32x16 sc[5];
#pragma unroll
        for (int kb = 0; kb < 5; ++kb) { sc[kb] = (f32x16){0.f, 0.f, 0.f, 0.f, 0.f, 0.f, 0.f, 0.f, 0.f, 0.f, 0.f, 0.f, 0.f, 0.f, 0.f, 0.f};
#pragma unroll
            for (int s = 0; s < 4; ++s) { const bf16x8 kf = *(const LAS bf16x8*)(lds + T_KL + (rg * 32 + kb * 32 + ql) * KL_STRIDE + (16 * s + 8 * h) * 2);
                sc[kb] = __builtin_amdgcn_mfma_f32_32x32x16_bf16(kf, qf[s], sc[kb], 0, 0, 0); } }
        float mx = -1e30f;
#pragma unroll
        for (int kb = 0; kb < 5; ++kb)
#pragma unroll
            for (int r = 0; r < 16; ++r) { const int kr = kb * 32 + crow(r, h), dist = ql + 128 - kr, kpos = r0 - 128 + kr;
                const bool ok = (dist >= 0) && (dist < WINDOW) && (kpos >= 0);
                const float v = ok ? sc[kb][r] + bt[hl * 128 + (dist & 127)] : -1e30f;
                sc[kb][r] = v; mx = fmaxf(mx, v); }
        mx = fmaxf(mx, __shfl_xor(mx, 32));
        const float sink2 = ap->in[5][l * NHEAD + head] * LOG2E;
        mx = fmaxf(mx, sink2);
        float sum = 0.f;
#pragma unroll
        for (int kb = 0; kb < 5; ++kb)
#pragma unroll
            for (int r = 0; r < 16; ++r) { const float e = __builtin_amdgcn_exp2f(sc[kb][r] - mx); sc[kb][r] = e; sum += e; }
        sum += __shfl_xor(sum, 32);
        const float inv = 1.0f / (sum + __builtin_amdgcn_exp2f(sink2 - mx));
        f32x16 o[2];
        o[0] = (f32x16){0.f, 0.f, 0.f, 0.f, 0.f, 0.f, 0.f, 0.f, 0.f, 0.f, 0.f, 0.f, 0.f, 0.f, 0.f, 0.f}; o[1] = o[0];
#pragma unroll
        for (int kb = 0; kb < 5; ++kb)
#pragma unroll
            for (int s2 = 0; s2 < 2; ++s2) {
                v4u pw; pw.x = pk2(sc[kb][8 * s2 + 0] * inv, sc[kb][8 * s2 + 1] * inv); pw.y = pk2(sc[kb][8 * s2 + 2] * inv, sc[kb][8 * s2 + 3] * inv);
                pw.z = pk2(sc[kb][8 * s2 + 4] * inv, sc[kb][8 * s2 + 5] * inv); pw.w = pk2(sc[kb][8 * s2 + 6] * inv, sc[kb][8 * s2 + 7] * inv);
                const bf16x8 pa = __builtin_bit_cast(bf16x8, pw);
                const int kbase = rg * 32 + kb * 32 + 16 * s2 + 4 * h;
#pragma unroll
                for (int db = 0; db < 2; ++db) { const LAS unsigned char* vp = lds + T_VT + (db * 32 + ql) * VT_STRIDE + kbase * 2;
                    const v2u lo = *(const LAS v2u*)vp, hi = *(const LAS v2u*)(vp + 16);
                    const v4u vw = (v4u){lo.x, lo.y, hi.x, hi.y};
                    o[db] = __builtin_amdgcn_mfma_f32_32x32x16_bf16(pa, __builtin_bit_cast(bf16x8, vw), o[db], 0, 0, 0); } }
#pragma unroll
        for (int db = 0; db < 2; ++db) { float ov[16]; stage_tile(o[db], st, lane, ov);
            const size_t row = tokrow + (lane >> 1); const int col = head * HD + db * 32 + 16 * (lane & 1);
            gate_store16(ov, H + row * LDH + HGA + col, AC + row * LDAC + AC_A + col); }
    }
}

template <int W> __device__ __forceinline__ void pool_diff(const bf16* H, LAS unsigned char* lds, int tok0, int g, int tid) {
    const int cc = tid & 31, ts = tid >> 5, s0 = tok0 & (SEQ - 1);
    const int first = ts * 8 - (W - 1);
    v4u rows[W + 7];
#pragma unroll
    for (int i = 0; i < W + 7; ++i) { rows[i] = (v4u){0u, 0u, 0u, 0u};
        if (s0 + first + i >= 0) rows[i] = *(const GAS v4u*)(H + (size_t)(tok0 + first + i) * LDH + HU + g * 256 + cc * 8); }
    float S[8] = {0.f, 0.f, 0.f, 0.f, 0.f, 0.f, 0.f, 0.f};
#define POOL_ACC(sgn, rv) do { S[0] += sgn bfl((rv).x); S[1] += sgn bfh((rv).x); S[2] += sgn bfl((rv).y); S[3] += sgn bfh((rv).y); S[4] += sgn bfl((rv).z); S[5] += sgn bfh((rv).z); S[6] += sgn bfl((rv).w); S[7] += sgn bfh((rv).w); } while (0)
#pragma unroll
    for (int i = 0; i < W; ++i) POOL_ACC(+, rows[i]);
#pragma unroll
    for (int j = 0; j < 8; ++j) {
        if (j > 0) { POOL_ACC(+, rows[j + W - 1]); POOL_ACC(-, rows[j - 1]); }
        const int spos = s0 + ts * 8 + j; const float inv = 1.0f / (float)(spos + 1 < W ? spos + 1 : W);
        const v4u u = rows[j + W - 1]; v4u d;
        d.x = pk2(S[0] * inv - bfl(u.x), S[1] * inv - bfh(u.x)); d.y = pk2(S[2] * inv - bfl(u.y), S[3] * inv - bfh(u.y));
        d.z = pk2(S[4] * inv - bfl(u.z), S[5] * inv - bfh(u.z)); d.w = pk2(S[6] * inv - bfl(u.w), S[7] * inv - bfh(u.w));
        *(LAS v4u*)(lds + T_DL + (ts * 8 + j) * DL_STRIDE + cc * 16) = d; }
#undef POOL_ACC
}

__device__ __forceinline__ void pool_unit(KArgs ap, int l, LAS unsigned char* lds, int pu, int tid, int wave, int lane) {
    const bf16* H = (const bf16*)(ap->ws + WS_H); bf16* AC = (bf16*)(ap->ws + WS_AC);
    const int tt = pu >> 2, g = pu & 3, tok0 = tt * 128;
    if (g == 0) pool_diff<2>(H, lds, tok0, g, tid); else if (g == 1) pool_diff<4>(H, lds, tok0, g, tid); else if (g == 2) pool_diff<8>(H, lds, tok0, g, tid); else pool_diff<16>(H, lds, tok0, g, tid);
    __syncthreads();
    const int wr = wave >> 1, wc = wave & 1, ql = lane & 31, h = lane >> 5;
    const bf16* wp = (const bf16*)(ap->ws + WS_WP + (size_t)l * WP_BYTES) + (size_t)g * 256 * 256 + (size_t)(wc * 128 + ql) * 256 + 8 * h;
    f32x16 acc[4];
#pragma unroll
    for (int nb = 0; nb < 4; ++nb) acc[nb] = (f32x16){0.f, 0.f, 0.f, 0.f, 0.f, 0.f, 0.f, 0.f, 0.f, 0.f, 0.f, 0.f, 0.f, 0.f, 0.f, 0.f};
#pragma unroll 2
    for (int s = 0; s < 16; ++s) { const bf16x8 af = *(const LAS bf16x8*)(lds + T_DL + (wr * 32 + ql) * DL_STRIDE + (16 * s + 8 * h) * 2);
#pragma unroll
        for (int nb = 0; nb < 4; ++nb) { const bf16x8 bf = *(const GAS bf16x8*)(wp + (size_t)nb * 32 * 256 + 16 * s);
            acc[nb] = __builtin_amdgcn_mfma_f32_32x32x16_bf16(af, bf, acc[nb], 0, 0, 0); } }
    LAS float* st = (LAS float*)(lds + T_ST + wave * ST_WAVE);
    const float* pscale = ap->in[8] + l * 1024 + g * 256;
#pragma unroll
    for (int nb = 0; nb < 4; ++nb) { float ov[16]; stage_tile(acc[nb], st, lane, ov);
        const size_t row = (size_t)(tok0 + wr * 32 + (lane >> 1)); const int col = wc * 128 + nb * 32 + 16 * (lane & 1);
#pragma unroll
        for (int i = 0; i < 4; ++i) { const f32x4 ps = *(const GAS f32x4*)(pscale + col + 4 * i); ov[4 * i] *= ps.x; ov[4 * i + 1] *= ps.y; ov[4 * i + 2] *= ps.z; ov[4 * i + 3] *= ps.w; }
        gate_store16(ov, H + row * LDH + HGB + g * 256 + col, AC + row * LDAC + AC_B + g * 256 + col); }
}

__device__ __forceinline__ void t_phase_mfma(KArgs ap, int l, LAS unsigned char* lds) {
    int tid = threadIdx.x; asm volatile("" : "+v"(tid));
    const Ids I = phase_ids(); const int vcu = I.vcu, G = I.G, wave = I.wave, lane = I.lane;
    { const float* p = ap->in[1] + (size_t)l * MTOK * PLE; bf16* AC = (bf16*)(ap->ws + WS_AC);
      for (int i = vcu * 512 + tid; i < MTOK * PLE / 4; i += G * 512) { const int row = i >> 6, c4 = i & 63;
          const f32x4 v = *(const GAS f32x4*)(p + (size_t)row * PLE + 4 * c4); v2u o; o.x = pk2(v.x, v.y); o.y = pk2(v.z, v.w);
          *(GAS v2u*)(AC + (size_t)row * LDAC + AC_P + 4 * c4) = o; } }
    for (int au = vcu; au < 256; au += G) { attn_unit(ap, l, lds, au, tid, wave, lane); __syncthreads(); }
    for (int pu = vcu; pu < 256; pu += G) { pool_unit(ap, l, lds, pu, tid, wave, lane); __syncthreads(); }
}

__device__ __forceinline__ void ln_phase(KArgs ap, int l) {
    const Ids I = phase_ids(); const int vcu = I.vcu, G = I.G, wave = I.wave, lane = I.lane;
    const int gw = vcu * NWAVES + wave, NGW = G * NWAVES;
    const float* Y = (const float*)(ap->ws + WS_Y); bf16* xb = (bf16*)(ap->ws + WS_XB);
    const float* gain = ap->in[11] + l * DM; const float* bias = ap->in[12] + l * DM;
    for (int m = gw; m < MTOK; m += NGW) {
        const GAS f32x4* yr = (const GAS f32x4*)(Y + (size_t)m * DM) + lane;
        f32x4 v[8]; float s = 0.f;
#pragma unroll
        for (int j = 0; j < 8; ++j) { v[j] = yr[64 * j]; s += (v[j].x + v[j].y) + (v[j].z + v[j].w); }
        const float mean = wave_sum(s) * (1.f / DM); float s2 = 0.f;
#pragma unroll
        for (int j = 0; j < 8; ++j) { v[j] = v[j] - mean; s2 += (v[j].x * v[j].x + v[j].y * v[j].y) + (v[j].z * v[j].z + v[j].w * v[j].w); }
        const float rstd = 1.f / sqrtf(wave_sum(s2) * (1.f / DM) + LN_EPS);
        GAS f32x4* orow = (GAS f32x4*)(ap->out + (size_t)m * DM) + lane; GAS v2u* brow = (GAS v2u*)(xb + (size_t)m * DM) + lane;
#pragma unroll
        for (int j = 0; j < 8; ++j) { const f32x4 gn = *((const GAS f32x4*)gain + lane + 64 * j), bs = *((const GAS f32x4*)bias + lane + 64 * j);
            const f32x4 o = v[j] * rstd * gn + bs; orow[64 * j] = o; v2u w; w.x = pk2(o.x, o.y); w.y = pk2(o.z, o.w); brow[64 * j] = w; }
    }
}

__global__ void __launch_bounds__(NWAVES * 64, 2) hymba_fwd(Args args_unused) {
    extern __shared__ __attribute__((aligned(16))) unsigned char lds_raw[];
    LAS unsigned char* lds = (LAS unsigned char*)lds_raw;
    volatile LAS unsigned* MISC = (volatile LAS unsigned*)(lds + MISC_OFF);
    const KArgs kp = (KArgs)__builtin_amdgcn_kernarg_segment_ptr();
    for (int u = threadIdx.x; u < (LDS_BYTES - LDSCTL_OFF) / 4; u += NWAVES * 64) ((LAS unsigned*)(lds + LDSCTL_OFF))[u] = 0u;
    __syncthreads();
    XcdBarrier bar; bar.bar = (unsigned*)(kp->ws + WS_CTL) + CW_BAR; bar.x = 0; bar.st = nullptr;
    if (N_LAUNCHES == 1) bar = xcd_barrier_post((unsigned*)(kp->ws + WS_CTL) + CW_BAR, MISC + 8);
#define GRID_BAR() do { if (N_LAUNCHES == 1) xcd_barrier(bar); } while (0)
#define LAUNDER(p) asm volatile("" : "+s"(p))
#define IN(k) (kp->ph_lo <= (k) && (k) < kp->ph_hi)
#define BOTH(k) (IN(k) && IN((k) + 1))

    if ((PH_MASK & 1) && IN(0)) { KArgs a = kp; LAUNDER(a); p0_prologue(a, lds); if (BOTH(0)) GRID_BAR(); }

    for (int l = 0; l < DEPTH; ++l) {
        const int pb = 1 + 4 * l;
        if ((PH_MASK & 2) && IN(pb)) {
            KArgs a = kp; LAUNDER(a); unsigned char* ws = a->ws;
            pg8::Gemm g{(const bf16*)(ws + WS_XB), (const bf16*)(ws + WS_BT1 + (size_t)l * BT1_BYTES), MTOK, N1, DM}; pg8::StaticOrder S; S.init(MTOK, N1, gridDim.x, blockIdx.x);
            pg8::EpiH E{(bf16*)(ws + WS_H), a->in[3] + l * IN_COLS};
            pg8::gemm_phase<pg8::EpiH, pg8::StaticOrder, true>(lds, g, S, E);
            if (BOTH(pb)) GRID_BAR();
        }
        if ((PH_MASK & 4) && IN(pb + 1)) {
            KArgs a = kp; LAUNDER(a);
            if (T_NAIVE) t_phase_naive(a, l, lds); else t_phase_mfma(a, l, lds);
            if (BOTH(pb + 1)) GRID_BAR();
        }
        if ((PH_MASK & 8) && IN(pb + 2)) {
            KArgs a = kp; LAUNDER(a); unsigned char* ws = a->ws;
            pg8::Gemm g{(const bf16*)(ws + WS_AC), (const bf16*)(ws + WS_BT2 + (size_t)l * BT2_BYTES), MTOK, DM, K2}; pg8::StaticOrder S; S.init(MTOK, DM, gridDim.x, blockIdx.x);
            pg8::EpiY E{(const bf16*)(ws + WS_H), l == 0 ? a->in[0] : a->out, (float*)(ws + WS_Y)};
            pg8::gemm_phase<pg8::EpiY, pg8::StaticOrder, false>(lds, g, S, E);
            if (BOTH(pb + 2)) GRID_BAR();
        }
        if ((PH_MASK & 16) && IN(pb + 3)) {
            KArgs a = kp; LAUNDER(a);
            ln_phase(a, l);
            if (BOTH(pb + 3)) GRID_BAR();
        }
    }
#undef IN
#undef BOTH
}

extern "C" void kernel_launch(void* const* d_in, const int* in_sizes, int n_in, void* d_out, int out_size, void* d_ws, size_t ws_size, hipStream_t stream) {
    static int grid = 0;
    if (grid == 0) {
        if (n_in != 13 || in_sizes[0] != MTOK * DM || out_size != MTOK * DM || ws_size < WS_END) {
            fprintf(stderr, "kernel_launch: unexpected shapes: n_in %d in0 %d out %d ws %zu (need %zu)\n", n_in, n_in > 0 ? in_sizes[0] : -1, out_size, ws_size, (size_t)WS_END); grid = -1; return; }
        int dev = 0, cus = 0, per_cu = 0;
        if (hipGetDevice(&dev) != hipSuccess || hipDeviceGetAttribute(&cus, hipDeviceAttributeMultiprocessorCount, dev) != hipSuccess) { grid = -1; return; }
        if (hipFuncSetAttribute((const void*)hymba_fwd, hipFuncAttributeMaxDynamicSharedMemorySize, LDS_BYTES) != hipSuccess) { fprintf(stderr, "kernel_launch: hipFuncSetAttribute failed\n"); grid = -1; return; }
        if (hipOccupancyMaxActiveBlocksPerMultiprocessor(&per_cu, (const void*)hymba_fwd, NWAVES * 64, LDS_BYTES) != hipSuccess || per_cu < 1)
            fprintf(stderr, "kernel_launch: note: occupancy query reports %d workgroups per CU\n", per_cu);
        (void)hipGetLastError();
        grid = cus;
    }
    if (grid < 0) return;
    if (hipMemsetAsync((char*)d_ws + WS_CTL, 0, CTL_ZERO_BYTES, stream) != hipSuccess) return;
    Args a{};
    for (int i = 0; i < 13; ++i) a.in[i] = (const float*)d_in[i];
    a.out = (float*)d_out; a.ws = (unsigned char*)d_ws;
    for (int li = 0; li < N_LAUNCHES; ++li) {
        a.ph_lo = (N_LAUNCHES == 1) ? 0 : li; a.ph_hi = (N_LAUNCHES == 1) ? N_PHASES : li + 1; a.li = li;
        hipLaunchKernelGGL(hymba_fwd, dim3(grid), dim3(NWAVES * 64), LDS_BYTES, stream, a);
        const hipError_t le = hipPeekAtLastError();
        if (le != hipSuccess) { fprintf(stderr, "kernel_launch: launch %d failed: %s\n", li, hipGetErrorName(le)); break; }
    }
}
```
